# Optimizing an MI355X kernel written in HIP

```python
import math
import jax, jax.numpy as jnp
from jax import lax
import numpy as np

D_MODEL = 2048
BATCH = 16
SEQ = 2048
DEPTH = 1
DEC_BATCH = 16
DEC_SEQ = 16
PAST_LEN = 1024

CHUNK = 64
N_META = 16
N_HEADS = 8
D_HEAD = 64
D_VHEAD = 2 * D_HEAD
QK_W = N_HEADS * D_HEAD
D_ATTN = N_HEADS * D_VHEAD
C_CONV = D_MODEL // 2
CONV_WIDTH = 31
N_BUCKETS = 32
MAX_DISTANCE = 128
Q_BLOCK = 128
EPS = 1e-6
NEG = -1e30
SCALE = D_HEAD ** -0.5
IN_WIDTHS = (QK_W, QK_W, QK_W, QK_W, D_ATTN, D_ATTN, C_CONV, C_CONV, C_CONV, D_MODEL, D_MODEL)
D_IN = sum(IN_WIDTHS)
SPLIT_AT = tuple(int(s) for s in np.cumsum(IN_WIDTHS)[:-1])

kernel_name = 'hybrid_conformer_diffattn_stream_step'


def rmsnorm(x, g):
    x32 = x.astype(jnp.float32)
    y = x32 * lax.rsqrt(jnp.mean(x32 * x32, axis=-1, keepdims=True) + EPS)
    return (y * g.astype(jnp.float32)).astype(x.dtype)


def layernorm(x, g, b):
    x32 = x.astype(jnp.float32)
    mu = jnp.mean(x32, axis=-1, keepdims=True)
    xc = x32 - mu
    y = xc * lax.rsqrt(jnp.mean(xc * xc, axis=-1, keepdims=True) + EPS)
    return (y * g.astype(jnp.float32) + b.astype(jnp.float32)).astype(x.dtype)


def chunk_index(pos):
    return jnp.where(pos < N_META, 0, 1 + (pos - N_META) // CHUNK)


def relative_bias(q_pos, k_pos, table):
    rel = k_pos[None, :] - q_pos[:, None]
    half = N_BUCKETS // 2
    max_exact = half // 2
    n = jnp.abs(rel)
    n_f = jnp.maximum(n, 1).astype(jnp.float32)
    large = max_exact + (jnp.log(n_f / max_exact) / math.log(MAX_DISTANCE / max_exact)
                         * (half - max_exact)).astype(jnp.int32)
    large = jnp.minimum(large, half - 1)
    bucket = jnp.where(rel > 0, half, 0) + jnp.where(n < max_exact, n, large)
    return jnp.transpose(table[bucket], (2, 0, 1)).astype(jnp.float32)


def project_inputs(x, norm_gain, w_in, q_gain, k_gain):
    B, T, _ = x.shape
    u = jnp.einsum('btd,de->bte', rmsnorm(x, norm_gain), w_in)
    q1, q2, k1, k2, v, z_attn, a, g, z_conv, gate_c, gate_a = jnp.split(u, SPLIT_AT, axis=-1)

    def heads(t, gain):
        return rmsnorm(t.reshape(B, T, N_HEADS, D_HEAD), gain)

    q = jnp.concatenate([heads(q1, q_gain), heads(q2, q_gain)], axis=-1).transpose(0, 2, 1, 3)
    k = jnp.concatenate([heads(k1, k_gain), heads(k2, k_gain)], axis=-1).transpose(0, 2, 1, 3)
    v = v.reshape(B, T, N_HEADS, D_VHEAD).transpose(0, 2, 1, 3)
    glu = a * jax.nn.sigmoid(g)
    return q, k, v, z_attn, glu, z_conv, gate_c, gate_a


def diff_attention_block(q, k, v, bias, mask, lam, subln_g, lam_init):
    B, H, Tq, _ = q.shape
    Tk = k.shape[2]
    qm = q.reshape(B, H, Tq, 2, D_HEAD)
    km = k.reshape(B, H, Tk, 2, D_HEAD)
    s = jnp.einsum('bhqmd,bhkmd->bhmqk', qm, km).astype(jnp.float32) * SCALE + bias[None, :, None]
    if mask is not None:
        s = jnp.where(mask, s, NEG)
    p = jax.nn.softmax(s, axis=-1)
    a = p[:, :, 0] - lam * p[:, :, 1]
    o = jnp.einsum('bhqk,bhkd->bhqd', a.astype(v.dtype), v)
    return rmsnorm(o, subln_g) * (1.0 - lam_init)


def prompt_attention(q, k, v, rel_table, lam, subln_g, lam_init):
    B, H, L, _ = q.shape
    n_blk = -(-L // Q_BLOCK)
    L_pad = n_blk * Q_BLOCK
    qb = jnp.pad(q, ((0, 0), (0, 0), (0, L_pad - L), (0, 0)))
    qb = qb.reshape(B, H, n_blk, Q_BLOCK, D_VHEAD).transpose(2, 0, 1, 3, 4)
    k_pos = jnp.arange(L)
    k_chunk = chunk_index(k_pos)

    def one_block(args):
        q_blk, blk = args
        q_pos = blk * Q_BLOCK + jnp.arange(Q_BLOCK)
        bias = relative_bias(q_pos, k_pos, rel_table)
        mask = k_chunk[None, :] <= chunk_index(q_pos)[:, None]
        return diff_attention_block(q_blk, k, v, bias, mask, lam, subln_g, lam_init)

    o = lax.map(one_block, (qb, jnp.arange(n_blk)))
    return o.transpose(1, 2, 0, 3, 4).reshape(B, H, L_pad, D_VHEAD)[:, :, :L]


def causal_depthwise(u_padded, w, b):
    y = lax.conv_general_dilated(u_padded, w[:, None, :].astype(u_padded.dtype), (1,), 'VALID',
                                 dimension_numbers=('NWC', 'WIO', 'NWC'),
                                 feature_group_count=C_CONV)
    return y + b


def finish_layer(x, o_attn, glu_padded, z_attn, z_conv, gate_c, gate_a,
                 conv_w, conv_b, ln_g, ln_b, w_branch_out, w_out):
    B, T, _ = x.shape
    attn = o_attn.transpose(0, 2, 1, 3).reshape(B, T, D_ATTN) * jax.nn.silu(z_attn)
    conv = causal_depthwise(glu_padded, conv_w, conv_b)
    conv = jax.nn.silu(layernorm(conv, ln_g, ln_b)) * jax.nn.silu(z_conv)
    merged = (jax.nn.sigmoid(gate_c) * jnp.einsum('btc,cd->btd', conv, w_branch_out[0])
              + jax.nn.sigmoid(gate_a) * jnp.einsum('btc,cd->btd', attn, w_branch_out[1]))
    return x + jnp.einsum('btd,de->bte', merged, w_out)


def setup_inputs(seed: int = 0) -> dict:
    key = jax.random.key(seed)
    ks = jax.random.split(key, 20)
    f32 = jnp.float32
    nrm = lambda k, shape, s: jax.random.normal(k, shape, f32) * s
    return {
        'x_prompt': nrm(ks[0], (BATCH, SEQ, D_MODEL), 1.0),
        'x_sample': nrm(ks[1], (DEC_BATCH, DEC_SEQ, D_MODEL), 1.0),
        'cache_k': nrm(ks[2], (DEPTH, DEC_BATCH, N_HEADS, PAST_LEN, D_VHEAD), 1.0),
        'cache_v': nrm(ks[3], (DEPTH, DEC_BATCH, N_HEADS, PAST_LEN, D_VHEAD), 1.0),
        'state_conv': nrm(ks[4], (DEPTH, DEC_BATCH, CONV_WIDTH - 1, C_CONV), 0.5),
        'meta_tokens': nrm(ks[5], (N_META, D_MODEL), 1.0),
        'rel_bias': nrm(ks[6], (N_BUCKETS, N_HEADS), 0.5),
        'norm_gain': 1.0 + nrm(ks[7], (DEPTH, D_MODEL), 0.02),
        'w_in': nrm(ks[8], (DEPTH, D_MODEL, D_IN), D_MODEL ** -0.5),
        'q_norm_gain': 1.0 + nrm(ks[9], (DEPTH, N_HEADS, D_HEAD), 0.02),
        'k_norm_gain': 1.0 + nrm(ks[10], (DEPTH, N_HEADS, D_HEAD), 0.02),
        'lambda_qk': nrm(ks[11], (DEPTH, 4, D_HEAD), 0.1),
        'subln_gain': 1.0 + nrm(ks[12], (DEPTH, D_VHEAD), 0.02),
        'conv_w': nrm(ks[13], (DEPTH, CONV_WIDTH, C_CONV), CONV_WIDTH ** -0.5),
        'conv_b': nrm(ks[14], (DEPTH, C_CONV), 0.01),
        'conv_ln_gain': 1.0 + nrm(ks[15], (DEPTH, C_CONV), 0.02),
        'conv_ln_bias': nrm(ks[16], (DEPTH, C_CONV), 0.01),
        'w_branch_out': nrm(ks[17], (DEPTH, 2, C_CONV, D_MODEL), C_CONV ** -0.5),
        'w_out': nrm(ks[18], (DEPTH, D_MODEL, D_MODEL), D_MODEL ** -0.5),
    }


def reference(x_prompt, x_sample, cache_k, cache_v, state_conv, meta_tokens, rel_bias,
              norm_gain, w_in, q_norm_gain, k_norm_gain, lambda_qk, subln_gain,
              conv_w, conv_b, conv_ln_gain, conv_ln_bias, w_branch_out, w_out):
    B = x_prompt.shape[0]
    T_s = x_sample.shape[1]
    past = cache_k.shape[3]
    meta = jnp.broadcast_to(meta_tokens.astype(x_prompt.dtype)[None], (B, N_META, D_MODEL))
    x_p = jnp.concatenate([meta, x_prompt], axis=1)
    x_s = x_sample
    q_pos_s = past + jnp.arange(T_s)
    k_pos_s = jnp.arange(past + T_s)
    k_p_rows, v_p_rows, conv_p_rows, k_s_rows, v_s_rows, conv_s_rows = [], [], [], [], [], []
    for layer in range(DEPTH):
        lam_init = 0.8 - 0.6 * math.exp(-0.3 * layer)
        lq = lambda_qk[layer].astype(jnp.float32)
        lam = jnp.exp(jnp.sum(lq[0] * lq[1])) - jnp.exp(jnp.sum(lq[2] * lq[3])) + lam_init
        q_p, k_p, v_p, za_p, glu_p, zc_p, gc_p, ga_p = project_inputs(
            x_p, norm_gain[layer], w_in[layer], q_norm_gain[layer], k_norm_gain[layer])
        o_p = prompt_attention(q_p, k_p, v_p, rel_bias, lam, subln_gain[layer], lam_init)
        glu_pad_p = jnp.concatenate(
            [jnp.zeros((B, CONV_WIDTH - 1, C_CONV), glu_p.dtype), glu_p], axis=1)
        k_p_rows.append(k_p)
        v_p_rows.append(v_p)
        conv_p_rows.append(glu_pad_p[:, -(CONV_WIDTH - 1):])
        x_p = finish_layer(x_p, o_p, glu_pad_p, za_p, zc_p, gc_p, ga_p, conv_w[layer], conv_b[layer],
                           conv_ln_gain[layer], conv_ln_bias[layer], w_branch_out[layer], w_out[layer])
        q_s, k_s, v_s, za_s, glu_s, zc_s, gc_s, ga_s = project_inputs(
            x_s, norm_gain[layer], w_in[layer], q_norm_gain[layer], k_norm_gain[layer])
        k_all = jnp.concatenate([cache_k[layer].astype(k_s.dtype), k_s], axis=2)
        v_all = jnp.concatenate([cache_v[layer].astype(v_s.dtype), v_s], axis=2)
        bias_s = relative_bias(q_pos_s, k_pos_s, rel_bias)
        o_s = diff_attention_block(q_s, k_all, v_all, bias_s, None, lam, subln_gain[layer], lam_init)
        glu_pad_s = jnp.concatenate([state_conv[layer].astype(glu_s.dtype), glu_s], axis=1)
        k_s_rows.append(k_s)
        v_s_rows.append(v_s)
        conv_s_rows.append(glu_pad_s[:, -(CONV_WIDTH - 1):])
        x_s = finish_layer(x_s, o_s, glu_pad_s, za_s, zc_s, gc_s, ga_s, conv_w[layer], conv_b[layer],
                           conv_ln_gain[layer], conv_ln_bias[layer], w_branch_out[layer], w_out[layer])
    y_prompt = x_p[:, N_META:]
    y_sample = x_s
    k_prompt = jnp.stack(k_p_rows)
    v_prompt = jnp.stack(v_p_rows)
    conv_prompt = jnp.stack(conv_p_rows)
    k_sample = jnp.stack(k_s_rows)
    v_sample = jnp.stack(v_s_rows)
    conv_sample = jnp.stack(conv_s_rows)
    return (y_prompt, y_sample, k_prompt, v_prompt, conv_prompt, k_sample, v_sample, conv_sample)
```

```cpp
#include <hip/hip_runtime.h>
#include <cstdio>
#include <cstdint>

#define LAS __attribute__((address_space(3)))
#define GAS __attribute__((address_space(1)))
typedef unsigned short bf16_t;
typedef short bf16x8 __attribute__((ext_vector_type(8)));
typedef short s16x4 __attribute__((ext_vector_type(4)));
typedef float f32x2 __attribute__((ext_vector_type(2)));
typedef float f32x4 __attribute__((ext_vector_type(4)));
typedef float f32x16 __attribute__((ext_vector_type(16)));
typedef unsigned u32x2 __attribute__((ext_vector_type(2)));
typedef unsigned u32x4 __attribute__((ext_vector_type(4)));
typedef __bf16 bf16x2_t __attribute__((ext_vector_type(2)));

constexpr int DM = 2048, NB = 16, SEQ = 2048, NMETA = 16, LP = NMETA + SEQ, NH = 8, CC = 1024, CW = 31, DIN = 11264;
constexpr int SB = 16, SS = 16, PAST = 1024;
constexpr int ROW_S = NB * SEQ;
constexpr int ROW_M = ROW_S + SB * SS;
constexpr int MROWS = 33280;
constexpr float EPS = 1e-6f;
constexpr float LOG2E = 1.4426950408889634f;
constexpr float QSCALE = 0.125f * LOG2E;
constexpr size_t OFF_YP = 0, OFF_YS = OFF_YP + (size_t)NB * SEQ * DM, OFF_KP = OFF_YS + (size_t)SB * SS * DM, OFF_VP = OFF_KP + (size_t)NB * NH * LP * 128,
                 OFF_CP = OFF_VP + (size_t)NB * NH * LP * 128, OFF_KS = OFF_CP + (size_t)NB * 30 * CC, OFF_VS = OFF_KS + (size_t)SB * NH * SS * 128,
                 OFF_CS = OFF_VS + (size_t)SB * NH * SS * 128, OUT_TOTAL = OFF_CS + (size_t)SB * 30 * CC;
constexpr size_t MiB = 1u << 20;
constexpr size_t WS_CTL = 0, CTL_ZERO_BYTES = 1 * MiB;
constexpr size_t WS_W1T = 1 * MiB, WS_WBT = 45 * MiB, WS_WOT = 53 * MiB;
constexpr size_t WS_KMB = 61 * MiB, WS_VMB = WS_KMB + 128 * 1024, WS_KSB = 62 * MiB, WS_VSB = 64 * MiB, WS_QS = 66 * MiB;
constexpr size_t WS_H = 67 * MiB, WS_CA = 67 * MiB;
constexpr size_t WS_QB = 197 * MiB, WS_KB = 261 * MiB, WS_VB = 325 * MiB, WS_MG = 197 * MiB;
constexpr size_t WS_ZA = 389 * MiB, WS_GLU = 454 * MiB, WS_ZC = 522 * MiB, WS_GC = 587 * MiB, WS_GA = 716 * MiB;
constexpr size_t WS_KCB = 845 * MiB, WS_VCB = 877 * MiB, WS_H8 = 909 * MiB, WS_W8 = 974 * MiB, WS_END = 982 * MiB;
constexpr int GLU_PB = 30 + NMETA + SEQ, GLU_S0 = NB * GLU_PB, GLU_SB = 30 + SS, GLU_ROWS = GLU_S0 + SB * GLU_SB + 32;
constexpr int CW_BAR = 4096, CW_Q = 2048, CW_GQ = 32768;

constexpr int RING_BYTES = 131072, LDSCTL_OFF = RING_BYTES, MISC_OFF = LDSCTL_OFF + 320, AUX_OFF = RING_BYTES + 1024, LDS_BYTES = 147456;
constexpr int NWAVES = 8;

__device__ __forceinline__ unsigned cvtpk(float lo, float hi) { f32x2 v = {lo, hi}; bf16x2_t b = __builtin_convertvector(v, bf16x2_t); return __builtin_bit_cast(unsigned, b); }
__device__ __forceinline__ float bflo(unsigned w) { return __uint_as_float(w << 16); }
__device__ __forceinline__ float bfhi(unsigned w) { return __uint_as_float(w & 0xffff0000u); }
__device__ __forceinline__ float sigmoidf_(float x) { return __builtin_amdgcn_rcpf(1.f + __builtin_amdgcn_exp2f(-LOG2E * x)); }
__device__ __forceinline__ float siluf_(float x) { return x * sigmoidf_(x); }
__device__ __forceinline__ u32x4 pack8(const f32x4& a, const f32x4& b) { u32x4 w; w.x = cvtpk(a[0], a[1]); w.y = cvtpk(a[2], a[3]); w.z = cvtpk(b[0], b[1]); w.w = cvtpk(b[2], b[3]); return w; }
#define LDS_WAIT() asm volatile("s_waitcnt lgkmcnt(0)" ::: "memory")
#define VM_WAIT() asm volatile("s_waitcnt vmcnt(0)" ::: "memory")

namespace pg8 {
constexpr int BM = 256, BK = 64, HALF = 128, HTB = HALF * BK * 2, STAGE_BYTES = 8 * HTB, NXCD = 8, WGM = 4;
__host__ __device__ __forceinline__ int lds_byte(int r, int c) { const int st = (r >> 4) * 2 + (c >> 5), rr = r & 15, cc = c & 31, ob = rr * 64 + cc * 2; return st * 1024 + (ob ^ (((ob >> 9) & 1) << 5)); }
__host__ __device__ __forceinline__ void stage_rc(int b, int& R, int& C) { const int st = b / 1024, sb = b % 1024, swz = sb ^ (((sb >> 9) & 1) << 5); R = (st >> 1) * 16 + swz / 64; C = (st & 1) * 32 + (swz % 64) / 2; }
__host__ __device__ __forceinline__ int perm32(int rho) { const int n = rho >> 4, i = rho & 15; return 8 * (i >> 2) + 4 * n + (i & 3); }

struct Unit { int pm, pn, ko, aux; };
struct Gemm { const bf16_t* A; const bf16_t* Bt; int lda, ldb, K; };

__device__ __forceinline__ void tile_of(int L, int nM, int nN, int& pm, int& pn) {
    const int nwg = nM * nN; int wgid = L;
    { const int q = nwg / NXCD, r = nwg % NXCD, xcd = wgid % NXCD, off = wgid / NXCD; wgid = (xcd < r ? xcd * (q + 1) : r * (q + 1) + (xcd - r) * q) + off; }
    const int nig = WGM * nN, gid = wgid / nig, fm = gid * WGM, gsz = (nM - fm) < WGM ? (nM - fm) : WGM;
    pm = fm + ((wgid % nig) % gsz); pn = (wgid % nig) / gsz;
}

struct DynQ { unsigned* ctr; LAS unsigned* mail; int x, slot, nslot, nwg; };
__device__ __forceinline__ unsigned dq_issue(const DynQ& q, int cursor) {
    unsigned k = 0u;
    if (threadIdx.x == 0) k = __hip_atomic_fetch_add(q.ctr + 64 * cursor, 1u, __ATOMIC_RELAXED, __HIP_MEMORY_SCOPE_AGENT);
    return k;
}
__device__ __forceinline__ int dq_finish(const DynQ& q, int& cursor, unsigned k0) {
    if (threadIdx.x == 0) {
        int L = -1, y = cursor; unsigned k = k0;
        for (int tries = 0; ; ) {
            const long Lc = ((long)k + 2 * q.nslot) * 8 + y;
            if (Lc < q.nwg) { L = (int)Lc; break; }
            if (++tries == 8) break;
            y = (y + 1) & 7; k = __hip_atomic_fetch_add(q.ctr + 64 * y, 1u, __ATOMIC_RELAXED, __HIP_MEMORY_SCOPE_AGENT);
        }
        q.mail[0] = (unsigned)L; q.mail[1] = (unsigned)y;
    }
    asm volatile("s_waitcnt lgkmcnt(0)" ::: "memory"); __builtin_amdgcn_s_barrier(); asm volatile("" ::: "memory");
    const int L = __builtin_amdgcn_readfirstlane((int)q.mail[0]); cursor = __builtin_amdgcn_readfirstlane((int)q.mail[1]);
    return L;
}

typedef int v4i32 __attribute__((ext_vector_type(4)));
typedef int v8i32 __attribute__((ext_vector_type(8)));
template <class Epi, class Sched, bool ALIGN_EPI, bool FP8 = false, bool DYN = false>
__device__ __forceinline__ void gemm_phase(LAS unsigned char* lds, const Gemm g, const Sched& S, const Epi& E) {
    const int tid = threadIdx.x, wid = __builtin_amdgcn_readfirstlane(tid >> 6), lane = tid & 63, wr = wid >> 2, wc = wid & 3, fr = lane & 15, fq = lane >> 4;
    const int nt = g.K / BK;
    unsigned voffA[2], voffB[2];
#pragma unroll
    for (int i = 0; i < 2; ++i) { int R, C; stage_rc(tid * 16 + i * 8192, R, C); const int Rb = (R & ~31) + perm32(R & 31);
        voffA[i] = (unsigned)(R * g.lda + C) * 2u; voffB[i] = (unsigned)(Rb * g.ldb + C) * 2u; }
    const size_t kstep = (size_t)(BK * 2);
    const size_t hstepA = (size_t)HALF * g.lda * 2, hstepB = (size_t)HALF * g.ldb * 2;
    const unsigned ldsw = (unsigned)wid * 1024u;
    const int fcol = FP8 ? (fq >> 1) * 32 + (fq & 1) * 16 : fq * 8;
    const int aoff = lds_byte(wr * 64 + fr, fcol), boff = lds_byte(wc * 32 + fr, fcol);
    constexpr int KOFF = FP8 ? 16 : 1024;
    int sc_w = 121, sc_a = 127; asm volatile("" : "+v"(sc_w), "+v"(sc_a));
#define PG8_SA(b, h) (((b) * 2 + (h)) * HTB)
#define PG8_SB(b, h) ((4 + (b) * 2 + (h)) * HTB)
#define PG8_STAGE(bufoff, gbase, voff) do { _Pragma("unroll") for (int _i = 0; _i < 2; ++_i) \
        __builtin_amdgcn_global_load_lds((const unsigned*)((const char*)(gbase) + (voff)[_i]), (LAS unsigned*)(lds + (bufoff) + ldsw + _i * 8192), 16, 0, 0); } while (0)
#define PG8_LDA(dst, b, h) do { _Pragma("unroll") for (int m = 0; m < 4; ++m) _Pragma("unroll") for (int k = 0; k < 2; ++k) dst[m][k] = *(const LAS bf16x8*)(lds + PG8_SA(b, h) + aoff + m * 2048 + k * KOFF); } while (0)
#define PG8_LDB(dst, b, h) do { _Pragma("unroll") for (int n = 0; n < 2; ++n) _Pragma("unroll") for (int k = 0; k < 2; ++k) dst[n][k] = *(const LAS bf16x8*)(lds + PG8_SB(b, h) + boff + n * 2048 + k * KOFF); } while (0)
#define PG8_MMA(ai, bj, At, Bt) do { __builtin_amdgcn_s_setprio(1); _Pragma("unroll") for (int m = 0; m < 4; ++m) _Pragma("unroll") for (int n = 0; n < 2; ++n) { \
        if constexpr (FP8) { \
            const v8i32 bw_ = __builtin_shufflevector(__builtin_bit_cast(v4i32, Bt[n][0]), __builtin_bit_cast(v4i32, Bt[n][1]), 0, 1, 2, 3, 4, 5, 6, 7); \
            const v8i32 aw_ = __builtin_shufflevector(__builtin_bit_cast(v4i32, At[m][0]), __builtin_bit_cast(v4i32, At[m][1]), 0, 1, 2, 3, 4, 5, 6, 7); \
            asm volatile("v_mfma_scale_f32_16x16x128_f8f6f4 %0, %1, %2, %0, %3, %4 op_sel_hi:[0,0,0]" : "+v"(acc[ai][bj][m][n]) : "v"(bw_), "v"(aw_), "v"(sc_w), "v"(sc_a)); \
        } else { _Pragma("unroll") for (int k = 0; k < 2; ++k) acc[ai][bj][m][n] = __builtin_amdgcn_mfma_f32_16x16x32_bf16(Bt[n][k], At[m][k], acc[ai][bj][m][n], 0, 0, 0); } } \
        __builtin_amdgcn_s_setprio(0); } while (0)
#define PG8_WAIT_V(n) asm volatile("s_waitcnt vmcnt(" #n ")" ::: "memory")
#define PG8_WAIT_L(n) asm volatile("s_waitcnt lgkmcnt(" #n ")" ::: "memory")
#define PG8_BAR __builtin_amdgcn_s_barrier()
#define PG8_SCHED __builtin_amdgcn_sched_barrier(0)
    Unit cur, nxt, nn; int ui = 0; bool nxt_ok = false, nn_ok = false; int dq_cur = 0; unsigned dq_k0 = 0u;
    if constexpr (DYN) {
        static_assert(ALIGN_EPI, "the dequeue broadcast needs the two half-workgroups aligned at the epilogue");
        dq_cur = S.q.x;
        if (S.q.nslot > 0) {
            if (!S.map(S.q.slot * 8 + S.q.x, cur)) return;
            nxt_ok = S.map((S.q.nslot + S.q.slot) * 8 + S.q.x, nxt);
        } else {
            const int L0 = dq_finish(S.q, dq_cur, dq_issue(S.q, dq_cur)); if (L0 < 0 || !S.map(L0, cur)) return;
            const int L1 = dq_finish(S.q, dq_cur, dq_issue(S.q, dq_cur)); nxt_ok = L1 >= 0 && S.map(L1, nxt);
        }
    } else { if (!S.next(0, cur)) return; }
    f32x4 acc[2][2][4][2];
#pragma unroll
    for (int a = 0; a < 2; ++a)
#pragma unroll
        for (int b = 0; b < 2; ++b)
#pragma unroll
            for (int m = 0; m < 4; ++m)
#pragma unroll
                for (int n = 0; n < 2; ++n) acc[a][b][m][n] = (f32x4){0.f, 0.f, 0.f, 0.f};
    bf16x8 At[4][2], B0[2][2], B1[2][2];
    const char* cA = (const char*)g.A + (size_t)cur.pm * 2 * hstepA + (size_t)cur.ko * 2; const char* cB = (const char*)g.Bt + (size_t)cur.pn * 2 * hstepB + (size_t)cur.ko * 2;
    PG8_STAGE(PG8_SB(0, 0), cB, voffB); PG8_STAGE(PG8_SB(0, 1), cB + hstepB, voffB); PG8_STAGE(PG8_SA(0, 0), cA, voffA); PG8_STAGE(PG8_SA(0, 1), cA + hstepA, voffA);
    if (wr == 1) PG8_BAR;
    PG8_WAIT_V(2); PG8_BAR;
    PG8_STAGE(PG8_SB(1, 0), cB + kstep, voffB); PG8_STAGE(PG8_SA(1, 0), cA + kstep, voffA); PG8_STAGE(PG8_SB(1, 1), cB + hstepB + kstep, voffB);
    PG8_WAIT_V(6); PG8_BAR;
    for (;;) {
        bool has_next;
        if constexpr (DYN) has_next = nxt_ok; else has_next = S.next(ui + 1, nxt);
        const char* nA = has_next ? (const char*)g.A + (size_t)nxt.pm * 2 * hstepA + (size_t)nxt.ko * 2 : cA;
        const char* nB = has_next ? (const char*)g.Bt + (size_t)nxt.pn * 2 * hstepB + (size_t)nxt.ko * 2 : cB;
        for (int t = 0; t < nt; t += 2) {
            const bool last = (t == nt - 2);
            const char* a1 = cA + (size_t)(t + 1) * kstep;
            const char* a2 = last ? nA : cA + (size_t)(t + 2) * kstep; const char* b2 = last ? nB : cB + (size_t)(t + 2) * kstep;
            const char* a3 = a2 + kstep; const char* b3 = b2 + kstep;
            PG8_LDB(B0, 0, 0); PG8_LDB(B1, 0, 1); PG8_SCHED; PG8_LDA(At, 0, 0); PG8_STAGE(PG8_SA(1, 1), a1 + hstepA, voffA);
            PG8_WAIT_V(8); PG8_WAIT_L(0); PG8_BAR; PG8_MMA(0, 0, At, B0); PG8_MMA(0, 1, At, B1); PG8_BAR; PG8_SCHED;
            PG8_LDA(At, 0, 1); PG8_STAGE(PG8_SB(0, 0), b2, voffB); PG8_STAGE(PG8_SB(0, 1), b2 + hstepB, voffB); PG8_STAGE(PG8_SA(0, 0), a2, voffA);
            PG8_WAIT_V(8); PG8_WAIT_L(0); PG8_BAR; PG8_MMA(1, 0, At, B0); PG8_MMA(1, 1, At, B1); PG8_BAR; PG8_SCHED;
            PG8_LDB(B0, 1, 0); PG8_LDB(B1, 1, 1); PG8_SCHED; PG8_LDA(At, 1, 0); PG8_STAGE(PG8_SA(0, 1), a2 + hstepA, voffA);
            PG8_WAIT_V(8); PG8_WAIT_L(0); PG8_BAR; PG8_MMA(0, 0, At, B0); PG8_MMA(0, 1, At, B1); PG8_BAR; PG8_SCHED;
            PG8_LDA(At, 1, 1); PG8_STAGE(PG8_SB(1, 0), b3, voffB); PG8_STAGE(PG8_SB(1, 1), b3 + hstepB, voffB); PG8_STAGE(PG8_SA(1, 0), a3, voffA);
            PG8_WAIT_V(8); PG8_WAIT_L(0); PG8_BAR; PG8_MMA(1, 0, At, B0); PG8_MMA(1, 1, At, B1); PG8_BAR; PG8_SCHED;
        }
        if constexpr (ALIGN_EPI) { if (wr == 0) PG8_BAR; }
        if constexpr (FP8) asm volatile("s_nop 15\n\ts_nop 7" ::: "memory");
        if constexpr (DYN) { if (has_next) dq_k0 = dq_issue(S.q, dq_cur); }
        E(acc, cur, wr, wc, fr, fq);
        if (!has_next) break;
        if constexpr (DYN) { const int L2 = dq_finish(S.q, dq_cur, dq_k0); nn_ok = L2 >= 0 && S.map(L2, nn); }
#pragma unroll
        for (int a = 0; a < 2; ++a)
#pragma unroll
            for (int b = 0; b < 2; ++b)
#pragma unroll
                for (int m = 0; m < 4; ++m)
#pragma unroll
                    for (int n = 0; n < 2; ++n) acc[a][b][m][n] = (f32x4){0.f, 0.f, 0.f, 0.f};
        cur = nxt; cA = nA; cB = nB; ++ui;
        if constexpr (DYN) { nxt = nn; nxt_ok = nn_ok; }
        if constexpr (ALIGN_EPI) { if (wr == 1) PG8_BAR; }
    }
    PG8_WAIT_V(0);
    if constexpr (!ALIGN_EPI) { if (wr == 0) PG8_BAR; }
    PG8_BAR;
#undef PG8_SA
#undef PG8_SB
#undef PG8_STAGE
#undef PG8_LDA
#undef PG8_LDB
#undef PG8_MMA
#undef PG8_WAIT_V
#undef PG8_WAIT_L
#undef PG8_BAR
#undef PG8_SCHED
}
}

struct Args {
    const float* in[19];
    float* out; unsigned char* ws;
    int ph_lo, ph_hi, li, pad;
};
enum { I_XP = 0, I_XS, I_CK, I_CV, I_SC, I_META, I_RB, I_NG, I_WIN, I_QG, I_KG, I_LQK, I_SLG, I_CWT, I_CB, I_LNG, I_LNB, I_WB, I_WO };

struct SchedIn {
    pg8::DynQ q;
    __device__ __forceinline__ bool map(int L, pg8::Unit& u) const {
        constexpr int NREG = 129 * 28;
        u.ko = 0; u.aux = 0;
        if (L < NREG) { pg8::tile_of(L, 129, 28, u.pm, u.pn); return true; }
        const int e = L - NREG; if (e >= 16) return false;
        u.pm = 129; u.pn = e < 8 ? 4 + e : 8 + e; return true;
    }
    __device__ __forceinline__ bool next(int, pg8::Unit&) const { return false; }
};
struct SchedGate {
    pg8::DynQ q;
    __device__ __forceinline__ bool map(int L, pg8::Unit& u) const {
        if (L >= 129 * 16) return false;
        pg8::tile_of(L, 129, 16, u.pm, u.pn); u.ko = 0; u.aux = 0; return true;
    }
    __device__ __forceinline__ bool next(int, pg8::Unit&) const { return false; }
};

struct EpiIn {
    float* out; const float* qg; const float* kg;
    bf16_t *Qb, *Qs, *Kb, *Vb, *Kmb, *Vmb, *Ksb, *Vsb, *ZA, *GLU, *ZC, *GC, *GA; int pn_base;
    __device__ __forceinline__ void operator()(const f32x4 (&acc)[2][2][4][2], const pg8::Unit& u, int wr, int wc, int fr, int fq) const {
        asm volatile("" : "+v"(fr), "+v"(fq));
        const int pm = u.pm, pn = u.pn + pn_base;
        const int kind = pm < 128 ? 0 : (pm == 128 ? 1 : 2);
        if (pn < 8) {
            const bool isk = pn >= 4; const int head = 2 * (pn & 3) + (wc >> 1), map = wc & 1;
            const float* gp = (isk ? kg : qg) + head * 64 + 8 * fq;
            f32x4 gv[2][2];
#pragma unroll
            for (int bj = 0; bj < 2; ++bj)
#pragma unroll
                for (int n = 0; n < 2; ++n) gv[bj][n] = *(const f32x4*)(gp + 32 * bj + 4 * n);
            const float osc = isk ? 1.f : QSCALE;
#pragma unroll
            for (int ai = 0; ai < 2; ++ai)
#pragma unroll
                for (int m = 0; m < 4; ++m) {
                    float ss = 0.f;
#pragma unroll
                    for (int bj = 0; bj < 2; ++bj)
#pragma unroll
                        for (int n = 0; n < 2; ++n) { const f32x4 v = acc[ai][bj][m][n]; ss += (v[0] * v[0] + v[1] * v[1]) + (v[2] * v[2] + v[3] * v[3]); }
                    ss += __shfl_xor(ss, 16); ss += __shfl_xor(ss, 32);
                    const float rs = __builtin_amdgcn_rsqf(ss * (1.f / 64.f) + EPS) * osc;
                    f32x4 o[2][2];
#pragma unroll
                    for (int bj = 0; bj < 2; ++bj)
#pragma unroll
                        for (int n = 0; n < 2; ++n) o[bj][n] = acc[ai][bj][m][n] * gv[bj][n] * rs;
                    const int rl = ai * 128 + wr * 64 + m * 16 + fr;
                    if (kind == 0) {
                        const int b = pm >> 3, t = (pm & 7) * 256 + rl, bh = b * NH + head;
                        if (!isk) {
                            bf16_t* q = Qb + ((size_t)bh * SEQ + t) * 128 + map * 64 + 8 * fq;
#pragma unroll
                            for (int bj = 0; bj < 2; ++bj) *(u32x4*)(q + 32 * bj) = pack8(o[bj][0], o[bj][1]);
                        } else {
                            float* kf = out + OFF_KP + ((size_t)bh * LP + NMETA + t) * 128 + map * 64 + 8 * fq;
                            bf16_t* kb = Kb + ((size_t)bh * 32 + (t >> 6)) * 8192 + (map * 8 + fq) * 512 + (t & 63) * 8;
#pragma unroll
                            for (int bj = 0; bj < 2; ++bj) { *(f32x4*)(kf + 32 * bj) = o[bj][0]; *(f32x4*)(kf + 32 * bj + 4) = o[bj][1]; *(u32x4*)(kb + bj * 4 * 512) = pack8(o[bj][0], o[bj][1]); }
                        }
                    } else if (kind == 1) {
                        const int b = rl >> 4, s = rl & 15, bh = b * NH + head;
                        if (!isk) {
                            bf16_t* q = Qs + ((size_t)bh * SS + s) * 128 + map * 64 + 8 * fq;
#pragma unroll
                            for (int bj = 0; bj < 2; ++bj) *(u32x4*)(q + 32 * bj) = pack8(o[bj][0], o[bj][1]);
                        } else {
                            float* kf = out + OFF_KS + ((size_t)bh * SS + s) * 128 + map * 64 + 8 * fq;
                            bf16_t* kb = Ksb + (size_t)bh * 8192 + (map * 8 + fq) * 512 + s * 8;
#pragma unroll
                            for (int bj = 0; bj < 2; ++bj) { *(f32x4*)(kf + 32 * bj) = o[bj][0]; *(f32x4*)(kf + 32 * bj + 4) = o[bj][1]; *(u32x4*)(kb + bj * 4 * 512) = pack8(o[bj][0], o[bj][1]); }
                        }
                    } else if (isk && rl < NMETA) {
                        bf16_t* kb = Kmb + (size_t)head * 8192 + (map * 8 + fq) * 512 + rl * 8;
#pragma unroll
                        for (int bj = 0; bj < 2; ++bj) *(u32x4*)(kb + bj * 4 * 512) = pack8(o[bj][0], o[bj][1]);
                        for (int b = 0; b < NB; ++b) {
                            float* kf = out + OFF_KP + ((size_t)(b * NH + head) * LP + rl) * 128 + map * 64 + 8 * fq;
#pragma unroll
                            for (int bj = 0; bj < 2; ++bj) { *(f32x4*)(kf + 32 * bj) = o[bj][0]; *(f32x4*)(kf + 32 * bj + 4) = o[bj][1]; }
                        }
                    }
                }
        } else if (pn < 12) {
#pragma unroll
            for (int ai = 0; ai < 2; ++ai)
#pragma unroll
                for (int m = 0; m < 4; ++m) {
                    const int rl = ai * 128 + wr * 64 + m * 16 + fr;
#pragma unroll
                    for (int bj = 0; bj < 2; ++bj) {
                        const int head = 2 * (pn - 8) + bj; const f32x4 v0 = acc[ai][bj][m][0], v1 = acc[ai][bj][m][1]; const u32x4 w = pack8(v0, v1);
                        if (kind == 0) {
                            const int b = pm >> 3, t = (pm & 7) * 256 + rl, bh = b * NH + head;
                            float* vf = out + OFF_VP + ((size_t)bh * LP + NMETA + t) * 128 + 32 * wc + 8 * fq;
                            *(f32x4*)vf = v0; *(f32x4*)(vf + 4) = v1;
                            *(u32x4*)(Vb + ((size_t)bh * 32 + (t >> 6)) * 8192 + wc * 2048 + ((t >> 4) & 3) * 512 + (t & 15) * 32 + fq * 8) = w;
                        } else if (kind == 1) {
                            const int b = rl >> 4, s = rl & 15, bh = b * NH + head;
                            float* vf = out + OFF_VS + ((size_t)bh * SS + s) * 128 + 32 * wc + 8 * fq;
                            *(f32x4*)vf = v0; *(f32x4*)(vf + 4) = v1;
                            *(u32x4*)(Vsb + (size_t)bh * 8192 + wc * 2048 + s * 32 + fq * 8) = w;
                        } else if (rl < NMETA) {
                            *(u32x4*)(Vmb + (size_t)head * 8192 + wc * 2048 + rl * 32 + fq * 8) = w;
                            for (int b = 0; b < NB; ++b) { float* vf = out + OFF_VP + ((size_t)(b * NH + head) * LP + rl) * 128 + 32 * wc + 8 * fq; *(f32x4*)vf = v0; *(f32x4*)(vf + 4) = v1; }
                        }
                    }
                }
        } else if (pn >= 16 && pn < 24) {
            const int j0 = 128 * (pn - 16) + 32 * wc + 8 * fq;
#pragma unroll
            for (int ai = 0; ai < 2; ++ai)
#pragma unroll
                for (int m = 0; m < 4; ++m) {
                    const int rl = ai * 128 + wr * 64 + m * 16 + fr;
                    f32x4 o[2];
#pragma unroll
                    for (int n = 0; n < 2; ++n) { const f32x4 a = acc[ai][0][m][n], gg = acc[ai][1][m][n];
                        o[n] = (f32x4){a[0] * sigmoidf_(gg[0]), a[1] * sigmoidf_(gg[1]), a[2] * sigmoidf_(gg[2]), a[3] * sigmoidf_(gg[3])}; }
                    const u32x4 gw = pack8(o[0], o[1]);
                    if (kind == 0) {
                        const int b = pm >> 3, t = (pm & 7) * 256 + rl;
                        *(u32x4*)(GLU + ((size_t)b * GLU_PB + 30 + NMETA + t) * CC + j0) = gw;
                        if (t >= SEQ - 30) { float* cf = out + OFF_CP + ((size_t)b * 30 + (t - (SEQ - 30))) * CC + j0; *(f32x4*)cf = o[0]; *(f32x4*)(cf + 4) = o[1]; }
                    } else if (kind == 1) {
                        const int b = rl >> 4, s = rl & 15;
                        *(u32x4*)(GLU + ((size_t)GLU_S0 + b * GLU_SB + 30 + s) * CC + j0) = gw;
                        float* cf = out + OFF_CS + ((size_t)b * 30 + 14 + s) * CC + j0; *(f32x4*)cf = o[0]; *(f32x4*)(cf + 4) = o[1];
                    } else if (rl < NMETA) {
                        for (int b = 0; b < NB; ++b) *(u32x4*)(GLU + ((size_t)b * GLU_PB + 30 + rl) * CC + j0) = gw;
                    }
                }
        } else {
            if (pn < 16) act_store<true>(acc, ZA, CC, 256 * (pn - 12) + 32 * wc + 8 * fq, pm * 256 + wr * 64 + fr);
            else if (pn < 28) act_store<true>(acc, ZC, CC, 256 * (pn - 24) + 32 * wc + 8 * fq, pm * 256 + wr * 64 + fr);
            else if (pn < 36) act_store<false>(acc, GC, DM, 256 * (pn - 28) + 32 * wc + 8 * fq, pm * 256 + wr * 64 + fr);
            else act_store<false>(acc, GA, DM, 256 * (pn - 36) + 32 * wc + 8 * fq, pm * 256 + wr * 64 + fr);
        }
    }
    template <bool SIL> static __device__ __forceinline__ void act_store(const f32x4 (&acc)[2][2][4][2], bf16_t* base, int ld, int c0, int row0) {
#pragma unroll
        for (int ai = 0; ai < 2; ++ai)
#pragma unroll
            for (int m = 0; m < 4; ++m) {
                const int row = row0 + ai * 128 + m * 16;
#pragma unroll
                for (int bj = 0; bj < 2; ++bj) {
                    f32x4 o[2];
#pragma unroll
                    for (int n = 0; n < 2; ++n) { const f32x4 v = acc[ai][bj][m][n]; const f32x4 sg = (f32x4){sigmoidf_(v[0]), sigmoidf_(v[1]), sigmoidf_(v[2]), sigmoidf_(v[3])}; o[n] = SIL ? v * sg : sg; }
                    *(u32x4*)(base + (size_t)row * ld + c0 + 128 * bj) = pack8(o[0], o[1]);
                }
            }
    }
};

struct EpiGate {
    bf16_t *GC, *GA;
    __device__ __forceinline__ void operator()(const f32x4 (&acc)[2][2][4][2], const pg8::Unit& u, int wr, int wc, int fr, int fq) const {
        asm volatile("" : "+v"(fr), "+v"(fq));
        bf16_t* base = (u.pn < 8 ? GC : GA) + (size_t)(u.pm * 256 + wr * 64 + fr) * DM + 256 * (u.pn & 7) + 32 * wc + 8 * fq;
#pragma unroll
        for (int ai = 0; ai < 2; ++ai)
#pragma unroll
            for (int m = 0; m < 4; ++m)
#pragma unroll
                for (int bj = 0; bj < 2; ++bj) {
                    f32x4 o[2];
#pragma unroll
                    for (int n = 0; n < 2; ++n) { const f32x4 v = acc[ai][bj][m][n]; o[n] = (f32x4){sigmoidf_(v[0]), sigmoidf_(v[1]), sigmoidf_(v[2]), sigmoidf_(v[3])}; }
                    *(u32x4*)(base + (size_t)(ai * 128 + m * 16) * DM + 128 * bj) = pack8(o[0], o[1]);
                }
    }
};

struct SchedBr {
    int G, c;
    __device__ __forceinline__ bool next(int i, pg8::Unit& u) const {
        const int L = (i >> 1) * G + c; if (L >= 128 * 8) return false;
        pg8::tile_of(L, 128, 8, u.pm, u.pn); u.aux = i & 1; u.ko = (i & 1) * CC; return true;
    }
};
struct EpiBr {
    const bf16_t* GC; const bf16_t* GA; bf16_t* MG;
    __device__ __forceinline__ void operator()(const f32x4 (&acc)[2][2][4][2], const pg8::Unit& u, int wr, int wc, int fr, int fq) const {
        asm volatile("" : "+v"(fr), "+v"(fq));
        const bf16_t* gate = u.aux ? GA : GC;
        const size_t base = ((size_t)u.pm * 256 + wr * 64 + fr) * DM + u.pn * 256 + wc * 32 + 8 * fq;
#pragma unroll
        for (int ai = 0; ai < 2; ++ai) {
            u32x4 gw[4][2], pw[4][2];
#pragma unroll
            for (int m = 0; m < 4; ++m)
#pragma unroll
                for (int bj = 0; bj < 2; ++bj) { const size_t off = base + (size_t)(ai * 128 + m * 16) * DM + bj * 128; gw[m][bj] = *(const u32x4*)(gate + off); if (u.aux) pw[m][bj] = *(const u32x4*)(MG + off); }
            __builtin_amdgcn_sched_barrier(0);
#pragma unroll
            for (int m = 0; m < 4; ++m)
#pragma unroll
                for (int bj = 0; bj < 2; ++bj) {
                    const size_t off = base + (size_t)(ai * 128 + m * 16) * DM + bj * 128;
                    const u32x4 g = gw[m][bj]; const f32x4 a0 = acc[ai][bj][m][0], a1 = acc[ai][bj][m][1];
                    f32x4 o0 = (f32x4){bflo(g.x) * a0[0], bfhi(g.x) * a0[1], bflo(g.y) * a0[2], bfhi(g.y) * a0[3]};
                    f32x4 o1 = (f32x4){bflo(g.z) * a1[0], bfhi(g.z) * a1[1], bflo(g.w) * a1[2], bfhi(g.w) * a1[3]};
                    if (u.aux) { const u32x4 p = pw[m][bj]; o0 += (f32x4){bflo(p.x), bfhi(p.x), bflo(p.y), bfhi(p.y)}; o1 += (f32x4){bflo(p.z), bfhi(p.z), bflo(p.w), bfhi(p.w)}; }
                    *(u32x4*)(MG + off) = pack8(o0, o1);
                }
            __builtin_amdgcn_sched_barrier(0);
        }
    }
};
struct SchedOut {
    int G, c;
    __device__ __forceinline__ bool next(int i, pg8::Unit& u) const {
        const int L = i * G + c; if (L >= 128 * 8) return false;
        pg8::tile_of(L, 128, 8, u.pm, u.pn); u.aux = 0; u.ko = 0; return true;
    }
};
struct EpiOut {
    const float* xp; const float* xs; float* out;
    __device__ __forceinline__ void operator()(const f32x4 (&acc)[2][2][4][2], const pg8::Unit& u, int wr, int wc, int fr, int fq) const {
        asm volatile("" : "+v"(fr), "+v"(fq));
        const float* src; float* dst;
        if (u.pm < 128) { src = xp + (size_t)u.pm * 256 * DM; dst = out + OFF_YP + (size_t)u.pm * 256 * DM; }
        else { src = xs; dst = out + OFF_YS; }
        const size_t base = (size_t)(wr * 64 + fr) * DM + u.pn * 256 + wc * 32 + 8 * fq;
#pragma unroll
        for (int ai = 0; ai < 2; ++ai) {
            f32x4 xv[4][2][2];
#pragma unroll
            for (int m = 0; m < 4; ++m)
#pragma unroll
                for (int bj = 0; bj < 2; ++bj)
#pragma unroll
                    for (int n = 0; n < 2; ++n) xv[m][bj][n] = *(const f32x4*)(src + base + (size_t)(ai * 128 + m * 16) * DM + bj * 128 + 4 * n);
            __builtin_amdgcn_sched_barrier(0);
#pragma unroll
            for (int m = 0; m < 4; ++m)
#pragma unroll
                for (int bj = 0; bj < 2; ++bj)
#pragma unroll
                    for (int n = 0; n < 2; ++n) *(f32x4*)(dst + base + (size_t)(ai * 128 + m * 16) * DM + bj * 128 + 4 * n) = xv[m][bj][n] + acc[ai][bj][m][n];
            __builtin_amdgcn_sched_barrier(0);
        }
    }
};

#define XB_TMO      128
#define XB_XCNT(j)  (256  + 64 * (j))
#define XB_XSUB(j)  (1280 + 64 * (j))
#define XB_XGEN(j)  (2304 + 64 * (j))
#define XB_TOP      3328
#define XB_TOPGEN   3392
#define XCD_BAR_WORDS 3456
#define XB_SPIN_CAP (1u << 18)
__device__ __forceinline__ unsigned xb_ld(unsigned* p)              { return __hip_atomic_load(p, __ATOMIC_RELAXED, __HIP_MEMORY_SCOPE_AGENT); }
__device__ __forceinline__ unsigned xb_add(unsigned* p, unsigned v) { return __hip_atomic_fetch_add(p, v, __ATOMIC_RELAXED, __HIP_MEMORY_SCOPE_AGENT); }
__device__ __forceinline__ unsigned xb_xcc_id() { return (unsigned)__builtin_amdgcn_s_getreg((3 << 11) | 20) & 0xFu; }
#define XB_SPIN(cond, bar) do { unsigned _sp = 0; while (cond) { __builtin_amdgcn_s_sleep(1); \
    if ((++_sp & 255u) == 0u) { if (xb_ld(&(bar)[XB_TMO])) break; if (_sp > XB_SPIN_CAP) { atomicAdd(&(bar)[XB_TMO], 1u); break; } } } } while (0)
struct XcdBarrier { unsigned* bar; unsigned x; volatile LAS unsigned* st; };
__device__ __forceinline__ XcdBarrier xcd_barrier_post(unsigned* bar, volatile LAS unsigned* st) {
    XcdBarrier b; b.bar = bar; b.x = xb_xcc_id(); b.st = st;
    if (threadIdx.x == 0) (void)xb_add(&bar[XB_XCNT(b.x)], 1u);
    return b;
}
__device__ __forceinline__ void xcd_barrier_complete(unsigned* bar, unsigned x, unsigned& nloc, unsigned& nx) {
    const unsigned G = gridDim.x * gridDim.y * gridDim.z;
    unsigned sum, cnt, mine, sp = 0u;
    for (;;) {
        sum = 0u; cnt = 0u; mine = 0u;
#pragma unroll
        for (unsigned j = 0; j < 16; ++j) { const unsigned c = xb_ld(&bar[XB_XCNT(j)]); sum += c; cnt += (c > 0u) ? 1u : 0u; mine = (j == x) ? c : mine; }
        if (sum == G) break;
        __builtin_amdgcn_s_sleep(1);
        if ((++sp & 255u) == 0u) { if (xb_ld(&bar[XB_TMO])) break; if (sp > XB_SPIN_CAP) { atomicAdd(&bar[XB_TMO], 1u); break; } }
    }
    nloc = mine > 0u ? mine : 1u; nx = cnt > 0u ? cnt : 1u;
}
__device__ __forceinline__ void xcd_barrier(const XcdBarrier& b) {
    asm volatile("s_waitcnt vmcnt(0)" ::: "memory");
    __syncthreads();
    if (threadIdx.x == 0) {
        unsigned* bar = b.bar;
        __builtin_amdgcn_s_waitcnt(0);
        unsigned nloc = b.st[0], nx = b.st[1];
        if (nloc == 0u) { xcd_barrier_complete(bar, b.x, nloc, nx); b.st[0] = nloc; b.st[1] = nx; }
        const unsigned old = xb_add(&bar[XB_XSUB(b.x)], 1u);
        const unsigned gen = old / nloc;
        if (old + 1u == (gen + 1u) * nloc) {
            __builtin_amdgcn_fence(__ATOMIC_RELEASE, "agent");
            asm volatile("s_waitcnt vmcnt(0)" ::: "memory");
            const unsigned og = xb_add(&bar[XB_TOP], 1u);
            const unsigned tg = og / nx;
            if (og + 1u == (tg + 1u) * nx) xb_add(&bar[XB_TOPGEN], 1u);
            else XB_SPIN(xb_ld(&bar[XB_TOPGEN]) == tg, bar);
            __builtin_amdgcn_fence(__ATOMIC_ACQUIRE, "agent");
            xb_add(&bar[XB_XGEN(b.x)], 1u);
            asm volatile("s_waitcnt vmcnt(0)" ::: "memory");
        } else {
            XB_SPIN(xb_ld(&bar[XB_XGEN(b.x)]) == gen, bar);
            __builtin_amdgcn_fence(__ATOMIC_ACQUIRE, "agent");
            asm volatile("s_waitcnt vmcnt(0)" ::: "memory");
        }
    }
    __syncthreads();
}

__device__ __forceinline__ float wave_sum(float v) {
#pragma unroll
    for (int o = 1; o < 64; o <<= 1) v += __shfl_xor(v, o);
    return v;
}
template <bool F8>
__device__ __forceinline__ void p0_transpose_item(const float* W, int N, bf16_t* WT, int ldt, int drow0, int drow1, int dcol, LAS float* scr, int k0, int n0, int lane, float wsc = 1.f) {
    f32x4 wv[8];
#pragma unroll
    for (int i = 0; i < 8; ++i) wv[i] = *(const f32x4*)(W + (size_t)(k0 + 4 * i + (lane >> 4)) * N + n0 + 4 * (lane & 15));
#pragma unroll
    for (int i = 0; i < 8; ++i) { LAS float* d = scr + (4 * i + (lane >> 4)) * 65 + 4 * (lane & 15); d[0] = wv[i][0]; d[1] = wv[i][1]; d[2] = wv[i][2]; d[3] = wv[i][3]; }
    LDS_WAIT(); asm volatile("" ::: "memory");
    const int c = lane & 3;
#pragma unroll
    for (int j = 0; j < 4; ++j) { const int n = (lane >> 2) + 16 * j; const LAS float* s = scr + (8 * c) * 65 + n;
        const int drow = (n < 32 ? drow0 : drow1) + (n & 31);
        if constexpr (F8) {
            int w0 = __builtin_amdgcn_cvt_pk_fp8_f32(s[0 * 65] * 64.f, s[1 * 65] * 64.f, 0, false); w0 = __builtin_amdgcn_cvt_pk_fp8_f32(s[2 * 65] * 64.f, s[3 * 65] * 64.f, w0, true);
            int w1 = __builtin_amdgcn_cvt_pk_fp8_f32(s[4 * 65] * 64.f, s[5 * 65] * 64.f, 0, false); w1 = __builtin_amdgcn_cvt_pk_fp8_f32(s[6 * 65] * 64.f, s[7 * 65] * 64.f, w1, true);
            *(u32x2*)((unsigned char*)WT + (size_t)drow * ldt + dcol + k0 + 8 * c) = (u32x2){(unsigned)w0, (unsigned)w1};
        } else {
            u32x4 o; o.x = cvtpk(s[0 * 65] * wsc, s[1 * 65] * wsc); o.y = cvtpk(s[2 * 65] * wsc, s[3 * 65] * wsc); o.z = cvtpk(s[4 * 65] * wsc, s[5 * 65] * wsc); o.w = cvtpk(s[6 * 65] * wsc, s[7 * 65] * wsc);
            *(u32x4*)(WT + (size_t)drow * ldt + dcol + k0 + 8 * c) = o; } }
    LDS_WAIT(); asm volatile("" ::: "memory");
}
__device__ __forceinline__ int w1_dst_row(int sb) {
    if (sb < 64) { const int region = sb >> 4, head = (sb & 15) >> 1, eh = sb & 1, qk = region >> 1, map = region & 1;
        return 256 * (qk * 4 + (head >> 1)) + eh * 128 + 32 * ((head & 1) * 2 + map); }
    if (sb < 128) return 256 * 8 + (sb - 64) * 32;
    if (sb < 160) { const int idx = sb - 128; return 256 * (16 + (idx >> 2)) + 32 * (idx & 3); }
    if (sb < 192) { const int idx = sb - 160; return 256 * (16 + (idx >> 2)) + 128 + 32 * (idx & 3); }
    return 256 * 24 + (sb - 192) * 32;
}

namespace att {
constexpr int SLOT = 16384;
constexpr int LDS_X = 0;
constexpr int AUX_WSF = AUX_OFF, AUX_LUT = AUX_OFF + 2048;
constexpr float THR = 8.f;
__device__ __forceinline__ int crow(int r, int hi) { return (r & 3) + 8 * (r >> 2) + 4 * hi; }
__device__ __forceinline__ void glds16(const void* gsrc, unsigned lds_dst) { unsigned keep;
    asm volatile("s_mov_b32 %0, m0\n\ts_mov_b32 m0, %2\n\ts_nop 0\n\tglobal_load_lds_dwordx4 %1, off\n\ts_mov_b32 m0, %0" : "=&s"(keep) : "v"(gsrc), "s"(lds_dst) : "memory"); }
template <int N> __device__ __forceinline__ float dpp_ror(float v) { return __uint_as_float(__builtin_amdgcn_update_dpp(0u, __float_as_uint(v), 0x120 + N, 0xf, 0xf, false)); }
__device__ __forceinline__ float max3f(float a, float b, float c) { float r; asm("v_max3_f32 %0, %1, %2, %3" : "=v"(r) : "v"(a), "v"(b), "v"(c)); return r; }
#define SBAR() __builtin_amdgcn_sched_barrier(0)
__device__ __forceinline__ s16x4 vtr(const LAS unsigned char* p) { return __builtin_bit_cast(s16x4, __builtin_amdgcn_ds_read_tr16_b64_v4i16((LAS s16x4*)p)); }

struct Tensors {
    const bf16_t *Qb, *Qs, *Kb, *Vb, *Kmb, *Vmb, *Ksb, *Vsb, *Kcb, *Vcb, *ZA; bf16_t* CA;
    const float* rel_bias; const float* slg;
};

__device__ __forceinline__ void attn_unit(const Tensors& T, const int sample, const int b, const int h, const int j, LAS unsigned char* lds, const float lam) {
    const int tid = threadIdx.x, lane = tid & 63, r32 = lane & 31, hi = lane >> 5;
    const int wid = __builtin_amdgcn_readfirstlane(tid >> 6), map = wid >> 2, g = wid & 3;
    const int bh = b * NH + h;
    LAS float* wsf = (LAS float*)(lds + AUX_WSF) + wid * 64;
    LAS float* lut = (LAS float*)(lds + AUX_LUT);
    if (tid < 192) {
        const int rel = tid - 128, n = rel < 0 ? -rel : rel;
        const int bk = n < 8 ? n : min(15, 2 + (31 - __clz(n * n)));
        const int bucket = (rel > 0 ? 16 : 0) + bk;
        lut[tid] = (T.rel_bias[bucket * NH + h] - T.rel_bias[15 * NH + h]) * LOG2E;
    }
    const int NT = sample ? 17 : 2 * j + 3;
    const bool act_all = sample ? (g == 0) : true;
    const bool act_last = sample ? (g == 0) : (g >= 2);
    const int qpos0 = sample ? PAST : NMETA + 128 * j + 32 * g;
    bf16x8 qr[4];
    {
        const bf16_t* qp = sample ? T.Qs + ((size_t)bh * SS + r32) * 128 : T.Qb + ((size_t)bh * SEQ + 128 * j + 32 * g + r32) * 128;
        qp += map * 64 + hi * 8;
#pragma unroll
        for (int d0 = 0; d0 < 4; ++d0) qr[d0] = *(const bf16x8*)(qp + d0 * 16);
    }
    f32x16 o[4]; o[0] = f32x16{}; o[1] = f32x16{}; o[2] = f32x16{}; o[3] = f32x16{};
    f32x16 ol = f32x16{};
    const f32x16 zero16 = f32x16{};
    const bf16x8 ones8 = (bf16x8){0x3F80, 0x3F80, 0x3F80, 0x3F80, 0x3F80, 0x3F80, 0x3F80, 0x3F80};
    auto tile_k = [&](int it) -> const bf16_t* {
        if (sample) return it < 16 ? T.Kcb + ((size_t)bh * 16 + it) * 8192 : T.Ksb + (size_t)bh * 8192;
        return it == 0 ? T.Kmb + (size_t)h * 8192 : T.Kb + ((size_t)bh * 32 + (it - 1)) * 8192;
    };
    auto tile_v = [&](int it) -> const bf16_t* {
        if (sample) return it < 16 ? T.Vcb + ((size_t)bh * 16 + it) * 8192 : T.Vsb + (size_t)bh * 8192;
        return it == 0 ? T.Vmb + (size_t)h * 8192 : T.Vb + ((size_t)bh * 32 + (it - 1)) * 8192;
    };
#define ATT_DMA(t, slot) do { const bf16_t* kp_ = tile_k(t); const bf16_t* vp_ = tile_v(t); \
        _Pragma("unroll") for (int i_ = 0; i_ < 2; ++i_) { \
            glds16(kp_ + (2 * wid + i_) * 512 + lane * 8, (unsigned)__builtin_amdgcn_readfirstlane(lds0 + (slot) * 32768 + (2 * wid + i_) * 1024)); \
            glds16(vp_ + (2 * wid + i_) * 512 + lane * 8, (unsigned)__builtin_amdgcn_readfirstlane(lds0 + (slot) * 32768 + SLOT + (2 * wid + i_) * 1024)); } } while (0)
    const unsigned lds0 = (unsigned)(uintptr_t)lds;
    asm volatile("s_waitcnt vmcnt(0)" :: "v"(qr[0]), "v"(qr[1]), "v"(qr[2]), "v"(qr[3]) : "memory");
    ATT_DMA(0, 0); ATT_DMA(1, 1); ATT_DMA(2, 2);
    const int vlane = ((lane >> 4) & 1) * 32 + (lane & 3) * 8 + (4 * hi + ((lane & 15) >> 2)) * 64;
    for (int it = 0; it < NT; ++it) {
        const int so = (it & 3) * 32768;
        asm volatile("s_waitcnt vmcnt(8)" ::: "memory"); __builtin_amdgcn_s_barrier(); asm volatile("" ::: "memory");
        { const int tn = it + 3 < NT ? it + 3 : 0; ATT_DMA(tn, (it + 3) & 3); }
        const bool active = (it == NT - 1) ? act_last : act_all;
        if (active) {
            int kpos0, nvalid;
            if (sample) { kpos0 = 64 * it; nvalid = it < 16 ? 64 : 16; } else { kpos0 = it == 0 ? 0 : NMETA + 64 * (it - 1); nvalid = it == 0 ? 16 : 64; }
            f32x16 p0, p1;
            { const LAS unsigned char* kb = lds + so + map * 8192 + hi * 1024 + r32 * 16;
              bf16x8 kf[8];
#pragma unroll
              for (int d0 = 0; d0 < 4; ++d0) { kf[2 * d0] = *(const LAS bf16x8*)(kb + d0 * 2048); kf[2 * d0 + 1] = *(const LAS bf16x8*)(kb + d0 * 2048 + 512); }
              SBAR();
              p0 = __builtin_amdgcn_mfma_f32_32x32x16_bf16(kf[0], qr[0], zero16, 0, 0, 0); p1 = __builtin_amdgcn_mfma_f32_32x32x16_bf16(kf[1], qr[0], zero16, 0, 0, 0);
#pragma unroll
              for (int d0 = 1; d0 < 4; ++d0) { p0 = __builtin_amdgcn_mfma_f32_32x32x16_bf16(kf[2 * d0], qr[d0], p0, 0, 0, 0); p1 = __builtin_amdgcn_mfma_f32_32x32x16_bf16(kf[2 * d0 + 1], qr[d0], p1, 0, 0, 0); } }
            SBAR();
            const LAS unsigned char* vb = lds + so + SLOT + vlane;
            s16x4 va[8], vbb[8];
#define ATT_VRD(dst, db) do { _Pragma("unroll") for (int s_ = 0; s_ < 4; ++s_) { dst[2 * s_] = vtr(vb + (db) * 4096 + s_ * 1024); dst[2 * s_ + 1] = vtr(vb + (db) * 4096 + s_ * 1024 + 512); } } while (0)
#define ATT_VF(src, s_) ((bf16x8){src[2 * (s_)][0], src[2 * (s_)][1], src[2 * (s_)][2], src[2 * (s_)][3], src[2 * (s_) + 1][0], src[2 * (s_) + 1][1], src[2 * (s_) + 1][2], src[2 * (s_) + 1][3]})
            ATT_VRD(va, 0);
            SBAR();
            if (kpos0 + 63 - qpos0 > -128) {
                const int rb = kpos0 - (qpos0 + r32) + 128 + 4 * hi;
#pragma unroll
                for (int r = 0; r < 16; ++r) { const int i0 = rb + (r & 3) + 8 * (r >> 2); const int i1 = i0 + 32;
                    p0[r] += lut[min(max(i0, 0), 191)]; p1[r] += lut[min(max(i1, 0), 191)]; }
            }
            if (nvalid < 64) {
#pragma unroll
                for (int r = 0; r < 16; ++r) { if ((r & 3) + 8 * (r >> 2) + 4 * hi >= nvalid) p0[r] = -INFINITY; p1[r] = -INFINITY; }
            }
#pragma unroll
            for (int r = 0; r < 16; ++r) { p0[r] = __builtin_amdgcn_exp2f(p0[r]); p1[r] = __builtin_amdgcn_exp2f(p1[r]); }
            bf16x8 pa[4];
            { u32x4 w;
              w.x = cvtpk(p0[0], p0[1]); w.y = cvtpk(p0[2], p0[3]); w.z = cvtpk(p0[4], p0[5]); w.w = cvtpk(p0[6], p0[7]); pa[0] = __builtin_bit_cast(bf16x8, w);
              w.x = cvtpk(p0[8], p0[9]); w.y = cvtpk(p0[10], p0[11]); w.z = cvtpk(p0[12], p0[13]); w.w = cvtpk(p0[14], p0[15]); pa[1] = __builtin_bit_cast(bf16x8, w);
              w.x = cvtpk(p1[0], p1[1]); w.y = cvtpk(p1[2], p1[3]); w.z = cvtpk(p1[4], p1[5]); w.w = cvtpk(p1[6], p1[7]); pa[2] = __builtin_bit_cast(bf16x8, w);
              w.x = cvtpk(p1[8], p1[9]); w.y = cvtpk(p1[10], p1[11]); w.z = cvtpk(p1[12], p1[13]); w.w = cvtpk(p1[14], p1[15]); pa[3] = __builtin_bit_cast(bf16x8, w); }
            SBAR();
#pragma unroll
            for (int s_ = 0; s_ < 4; ++s_) ol = __builtin_amdgcn_mfma_f32_32x32x16_bf16(pa[s_], ones8, ol, 0, 0, 0);
#define ATT_PV(db, cur) do { _Pragma("unroll") for (int s_ = 0; s_ < 4; ++s_) o[db] = __builtin_amdgcn_mfma_f32_32x32x16_bf16(pa[s_], ATT_VF(cur, s_), o[db], 0, 0, 0); } while (0)
            ATT_VRD(vbb, 1); SBAR(); ATT_PV(0, va); SBAR();
            ATT_VRD(va, 2);  SBAR(); ATT_PV(1, vbb); SBAR();
            ATT_VRD(vbb, 3); SBAR(); ATT_PV(2, va); SBAR();
            ATT_PV(3, vbb); SBAR();
#undef ATT_VRD
#undef ATT_VF
#undef ATT_PV
        }
    }
    asm volatile("s_waitcnt vmcnt(0) lgkmcnt(0)" ::: "memory");
    __syncthreads();
    const bool fin = sample ? (g == 0) : true;
    LAS float* xr = (LAS float*)(lds + LDS_X + g * 16384);
    const int ch = lane & 15;
    const int nq = sample ? 16 : 32;
    const size_t row0 = sample ? (size_t)ROW_S + b * SS : (size_t)b * SEQ + 128 * j + 32 * g;
    u32x4 zv[8];
    if (fin && map == 0) {
#pragma unroll
        for (int i = 0; i < 8; ++i) { const int q = min(i * 4 + (lane >> 4), nq - 1); zv[i] = *(const u32x4*)(T.ZA + (row0 + q) * CC + h * 128 + ch * 8); }
    }
    if (fin && map == 1) {
        const float sc = -lam;
#pragma unroll
        for (int r = 0; r < 16; ++r) { const float rl = __builtin_amdgcn_rcpf(ol[r]) * sc;
#pragma unroll
            for (int db = 0; db < 4; ++db) xr[(db * 16 + r) * 64 + lane] = o[db][r] * rl; }
    }
    LDS_WAIT();
    __syncthreads();
    if (fin && map == 0) {
        float ssq[16];
#pragma unroll
        for (int r = 0; r < 16; ++r) { const float rl = __builtin_amdgcn_rcpf(ol[r]); float s2 = 0.f;
#pragma unroll
            for (int db = 0; db < 4; ++db) { const float v = o[db][r] * rl + xr[(db * 16 + r) * 64 + lane]; o[db][r] = v; s2 += v * v; }
            ssq[r] = s2; }
#pragma unroll
        for (int r = 0; r < 16; ++r) { float s2 = ssq[r];
            s2 += dpp_ror<8>(s2); s2 += dpp_ror<4>(s2); s2 += dpp_ror<2>(s2); s2 += dpp_ror<1>(s2);
            { auto rr = __builtin_amdgcn_permlane16_swap(__float_as_uint(s2), __float_as_uint(s2), false, false); s2 = __uint_as_float(rr[0]) + __uint_as_float(rr[1]); }
            ssq[r] = __builtin_amdgcn_rsqf(s2 * (1.f / 128.f) + EPS) * 0.8f; }
        LDS_WAIT();
        LAS bf16_t* stg = (LAS bf16_t*)xr;
#pragma unroll
        for (int r = 0; r < 16; ++r) { const int q = crow(r, hi);
#pragma unroll
            for (int db = 0; db < 4; ++db) stg[q * 136 + db * 32 + r32] = (bf16_t)(cvtpk(o[db][r] * ssq[r], 0.f) & 0xffffu); }
        LDS_WAIT();
        const f32x4 g0 = *(const f32x4*)(T.slg + ch * 8), g1 = *(const f32x4*)(T.slg + ch * 8 + 4);
#pragma unroll
        for (int i = 0; i < 8; ++i) {
            const int q = i * 4 + (lane >> 4);
            if (q < nq) {
                const u32x4 w = *(const LAS u32x4*)(stg + q * 136 + ch * 8);
                const u32x4 z = zv[i];
                u32x4 ow;
                ow.x = cvtpk(bflo(w.x) * g0[0] * bflo(z.x), bfhi(w.x) * g0[1] * bfhi(z.x)); ow.y = cvtpk(bflo(w.y) * g0[2] * bflo(z.y), bfhi(w.y) * g0[3] * bfhi(z.y));
                ow.z = cvtpk(bflo(w.z) * g1[0] * bflo(z.z), bfhi(w.z) * g1[1] * bfhi(z.z)); ow.w = cvtpk(bflo(w.w) * g1[2] * bflo(z.w), bfhi(w.w) * g1[3] * bfhi(z.w));
                *(u32x4*)(T.CA + (row0 + q) * DM + CC + h * 128 + ch * 8) = ow;
            }
        }
    }
    LDS_WAIT();
    __syncthreads();
}
}

struct ConvT { const bf16_t *GLU, *ZC; bf16_t* CA; };
struct ConvW { f32x2 W[CW]; f32x2 bias, gg, bb; };
__device__ __forceinline__ void conv_unit(const ConvT& T, const ConvW& P, int cu, LAS unsigned char* lds) {
    const int tid = threadIdx.x, lane = tid & 63, wid = __builtin_amdgcn_readfirstlane(tid >> 6);
    const int c2 = 2 * tid;
    const bool sample = cu >= 1024;
    const int b = sample ? cu - 1024 : cu >> 6, t0 = sample ? 0 : (cu & 63) * 32;
    const bf16_t* gin = T.GLU + (sample ? (size_t)GLU_S0 + b * GLU_SB : (size_t)b * GLU_PB + NMETA + t0) * CC + c2;
    const f32x2 (&W)[CW] = P.W; const f32x2 bias = P.bias;
    f32x2 acc[32];
#pragma unroll
    for (int o = 0; o < 32; ++o) acc[o] = bias;
    unsigned wa[16], wb[16];
#define CONV_LOAD(dst, i0) do { _Pragma("unroll") for (int k = 0; k < 16; ++k) if ((i0) + k < 62) dst[k] = *(const unsigned*)(gin + (size_t)((i0) + k) * CC); } while (0)
#define CONV_FMA(src, i0) do { _Pragma("unroll") for (int k = 0; k < 16; ++k) { const int i = (i0) + k; if (i < 62) { const f32x2 v = (f32x2){bflo(src[k]), bfhi(src[k])}; \
        _Pragma("unroll") for (int o = 0; o < 32; ++o) { const int w = i - o; if (w >= 0 && w < CW) acc[o] += v * W[w]; } } } } while (0)
    CONV_LOAD(wa, 0); CONV_LOAD(wb, 16);
    __builtin_amdgcn_sched_barrier(0);
    CONV_FMA(wa, 0);
    __builtin_amdgcn_sched_barrier(0);
    CONV_LOAD(wa, 32);
    __builtin_amdgcn_sched_barrier(0);
    CONV_FMA(wb, 16);
    __builtin_amdgcn_sched_barrier(0);
    CONV_LOAD(wb, 48);
    __builtin_amdgcn_sched_barrier(0);
    CONV_FMA(wa, 32);
    __builtin_amdgcn_sched_barrier(0);
    CONV_FMA(wb, 48);
#undef CONV_LOAD
#undef CONV_FMA
    const int nout = sample ? 16 : 32;
    const size_t row0 = sample ? (size_t)ROW_S + b * SS : (size_t)b * SEQ + t0;
    float s1[32], s2[32];
#pragma unroll
    for (int o = 0; o < 32; ++o) { s1[o] = acc[o].x + acc[o].y; s2[o] = acc[o].x * acc[o].x + acc[o].y * acc[o].y; }
#pragma unroll
    for (int step = 0; step < 5; ++step) {
        const int half = 16 >> step, bit = 32 >> step; const bool up = (lane & bit) != 0;
#pragma unroll
        for (int k = 0; k < half; ++k) {
            const float send1 = up ? s1[k] : s1[k + half], keep1 = up ? s1[k + half] : s1[k];
            const float send2 = up ? s2[k] : s2[k + half], keep2 = up ? s2[k + half] : s2[k];
            s1[k] = keep1 + __shfl_xor(send1, bit); s2[k] = keep2 + __shfl_xor(send2, bit);
        }
    }
    s1[0] += __shfl_xor(s1[0], 1); s2[0] += __shfl_xor(s2[0], 1);
    LAS float* red = (LAS float*)(lds);
    LAS float* stat = (LAS float*)(lds + 2048);
    if ((lane & 1) == 0) { red[(wid * 32 + (lane >> 1)) * 2] = s1[0]; red[(wid * 32 + (lane >> 1)) * 2 + 1] = s2[0]; }
    LDS_WAIT();
    __syncthreads();
    if (tid < 32) { float a = 0.f, q = 0.f;
#pragma unroll
        for (int w = 0; w < 8; ++w) { a += red[(w * 32 + tid) * 2]; q += red[(w * 32 + tid) * 2 + 1]; }
        const float mean = a * (1.f / CC); const float var = fmaxf(q * (1.f / CC) - mean * mean, 0.f);
        stat[tid * 2] = mean; stat[tid * 2 + 1] = __builtin_amdgcn_rsqf(var + EPS); }
    LDS_WAIT();
    __syncthreads();
    const f32x2 gg = P.gg, bb = P.bb;
    unsigned zc[32];
#pragma unroll
    for (int o = 0; o < 32; ++o) zc[o] = *(const unsigned*)(T.ZC + (row0 + min(o, nout - 1)) * CC + c2);
    __builtin_amdgcn_sched_barrier(0);
#pragma unroll
    for (int o = 0; o < 32; ++o) {
        if (o < nout) {
            const float mean = stat[o * 2], rstd = stat[o * 2 + 1];
            const f32x2 y = (acc[o] - mean) * rstd * gg + bb;
            const unsigned z = zc[o];
            *(unsigned*)(T.CA + (row0 + o) * DM + c2) = cvtpk(siluf_(y.x) * bflo(z), siluf_(y.y) * bfhi(z));
        }
    }
    LDS_WAIT();
    __syncthreads();
}

template <int KSTEPS>
__device__ __forceinline__ f32x4 mini_dot(const bf16_t* arow, const bf16_t* brow) {
    f32x4 acc = (f32x4){0.f, 0.f, 0.f, 0.f};
    bf16x8 a[8], b[8];
#pragma unroll
    for (int u = 0; u < 8; ++u) { a[u] = *(const bf16x8*)(arow + 32 * u); b[u] = *(const bf16x8*)(brow + 32 * u); }
    for (int k0 = 0; k0 < KSTEPS; k0 += 8) {
#pragma unroll
        for (int u = 0; u < 8; ++u) {
            acc = __builtin_amdgcn_mfma_f32_16x16x32_bf16(b[u], a[u], acc, 0, 0, 0);
            if (k0 + 8 < KSTEPS) { a[u] = *(const bf16x8*)(arow + 32 * (k0 + 8 + u)); b[u] = *(const bf16x8*)(brow + 32 * (k0 + 8 + u)); }
        }
    }
    return acc;
}
__device__ __forceinline__ void side_p3(const bf16_t* CA, const bf16_t* WBT, const bf16_t* GC, const bf16_t* GA, bf16_t* MG, int vcu) {
    const int tid = threadIdx.x, lane = tid & 63, wid = tid >> 6, fr = lane & 15, fq = lane >> 4;
    const int rh = vcu & 1, c0 = (vcu >> 1) * 16;
    const size_t row = (size_t)ROW_S + rh * 128 + wid * 16 + fr;
    const bf16_t* ar = CA + row * DM + 8 * fq; const bf16_t* br = WBT + (size_t)(c0 + fr) * DM + 8 * fq;
    const f32x4 x0 = mini_dot<32>(ar, br), x1 = mini_dot<32>(ar + CC, br + CC);
    const size_t off = row * DM + c0 + 4 * fq;
    const u32x2 gc = *(const u32x2*)(GC + off), ga = *(const u32x2*)(GA + off);
    u32x2 o; o.x = cvtpk(bflo(gc.x) * x0[0] + bflo(ga.x) * x1[0], bfhi(gc.x) * x0[1] + bfhi(ga.x) * x1[1]); o.y = cvtpk(bflo(gc.y) * x0[2] + bflo(ga.y) * x1[2], bfhi(gc.y) * x0[3] + bfhi(ga.y) * x1[3]);
    *(u32x2*)(MG + off) = o;
}
__device__ __forceinline__ void side_p4(const bf16_t* MG, const bf16_t* WOT, const float* xs, float* ys, int vcu) {
    const int tid = threadIdx.x, lane = tid & 63, wid = tid >> 6, fr = lane & 15, fq = lane >> 4;
    const int rh = vcu & 1, c0 = (vcu >> 1) * 16;
    const int r = rh * 128 + wid * 16 + fr;
    const f32x4 acc = mini_dot<64>(MG + ((size_t)ROW_S + r) * DM + 8 * fq, WOT + (size_t)(c0 + fr) * DM + 8 * fq);
    const size_t off = (size_t)r * DM + c0 + 4 * fq;
    *(f32x4*)(ys + off) = *(const f32x4*)(xs + off) + acc;
}

__global__ void __launch_bounds__(NWAVES * 64, 2) fwd_kernel(Args args) {
    extern __shared__ __attribute__((aligned(16))) unsigned char lds_raw[];
    LAS unsigned char* lds = (LAS unsigned char*)lds_raw;
    volatile LAS unsigned* MISC = (volatile LAS unsigned*)(lds + MISC_OFF);
    const int tid = threadIdx.x, lane = tid & 63, wave = __builtin_amdgcn_readfirstlane(tid >> 6);
    const int G = gridDim.x; const int bx = blockIdx.x; const int vcu = (G % 8 == 0) ? (bx % 8) * (G / 8) + bx / 8 : bx;
    unsigned char* ws = args.ws;
    unsigned* ctl = (unsigned*)(ws + WS_CTL);
    for (int u = tid; u < (LDS_BYTES - LDSCTL_OFF) / 4; u += NWAVES * 64) ((LAS unsigned*)(lds + LDSCTL_OFF))[u] = 0u;
    __syncthreads();
    XcdBarrier bar = xcd_barrier_post(ctl + CW_BAR + args.li * XCD_BAR_WORDS, MISC + 8);
    const int lo = args.ph_lo, hi = args.ph_hi;
#ifndef PH_MASK
#define PH_MASK 31
#endif
#define IN(k) (((PH_MASK >> (k)) & 1) && lo <= (k) && (k) < hi)
#define BOTH(k) (IN(k) && IN((k) + 1))

    bf16_t* W1T = (bf16_t*)(ws + WS_W1T); bf16_t* WBT = (bf16_t*)(ws + WS_WBT); bf16_t* WOT = (bf16_t*)(ws + WS_WOT);
    bf16_t* Hb = (bf16_t*)(ws + WS_H); bf16_t* CA = (bf16_t*)(ws + WS_CA); bf16_t* MG = (bf16_t*)(ws + WS_MG);
    bf16_t* Qb = (bf16_t*)(ws + WS_QB); bf16_t* Kb = (bf16_t*)(ws + WS_KB); bf16_t* Vb = (bf16_t*)(ws + WS_VB);
    bf16_t* Kmb = (bf16_t*)(ws + WS_KMB); bf16_t* Vmb = (bf16_t*)(ws + WS_VMB); bf16_t* Ksb = (bf16_t*)(ws + WS_KSB); bf16_t* Vsb = (bf16_t*)(ws + WS_VSB); bf16_t* Qs = (bf16_t*)(ws + WS_QS);
    bf16_t* ZA = (bf16_t*)(ws + WS_ZA); bf16_t* GLU = (bf16_t*)(ws + WS_GLU); bf16_t* ZC = (bf16_t*)(ws + WS_ZC); bf16_t* GC = (bf16_t*)(ws + WS_GC); bf16_t* GA = (bf16_t*)(ws + WS_GA);
    bf16_t* Kcb = (bf16_t*)(ws + WS_KCB); bf16_t* Vcb = (bf16_t*)(ws + WS_VCB);
    unsigned char* H8 = ws + WS_H8; unsigned char* W8 = ws + WS_W8;

    if (IN(0)) {
        const int gw = vcu * NWAVES + wave, NGW = G * NWAVES;
        LAS float* scr = (LAS float*)(lds + wave * 16384);
        constexpr int I_1 = 64 * 176, I_B = 2 * 32 * 32, I_O = 64 * 32;
        for (int it = gw; it < I_1 + I_B + I_O; it += NGW) {
            int r = it;
            if (r < I_1) { const int kb = r / 176, nb = r % 176;
                if (nb >= 112) p0_transpose_item<true>(args.in[I_WIN], DIN, (bf16_t*)W8, DM, (2 * nb - 224) * 32, (2 * nb - 223) * 32, 0, scr, 32 * kb, 64 * nb, lane);
                else p0_transpose_item<false>(args.in[I_WIN], DIN, W1T, DM, w1_dst_row(2 * nb), w1_dst_row(2 * nb + 1), 0, scr, 32 * kb, 64 * nb, lane);
                continue; }
            r -= I_1;
            if (r < I_B) { const int br = r / 1024, rr = r % 1024, kb = rr / 32, nb = rr % 32; p0_transpose_item<false>(args.in[I_WB] + (size_t)br * CC * DM, DM, WBT, DM, 64 * nb, 64 * nb + 32, br * CC, scr, 32 * kb, 64 * nb, lane); continue; }
            r -= I_B;
            { const int kb = r / 32, nb = r % 32; p0_transpose_item<false>(args.in[I_WO], DM, WOT, DM, 64 * nb, 64 * nb + 32, 0, scr, 32 * kb, 64 * nb, lane); }
        }
        {
            f32x4 gv[8];
#pragma unroll
            for (int jj = 0; jj < 8; ++jj) gv[jj] = *((const f32x4*)args.in[I_NG] + lane + 64 * jj);
            for (int m = gw; m < MROWS; m += NGW) {
                u32x2* o8 = (u32x2*)(Hb + (size_t)m * DM) + lane;
                unsigned* o4 = (unsigned*)(H8 + (size_t)m * DM) + lane;
                if (m >= ROW_M + NMETA) {
#pragma unroll
                    for (int jj = 0; jj < 8; ++jj) { o8[64 * jj] = (u32x2){0u, 0u}; o4[64 * jj] = 0u; }
                    continue;
                }
                const float* xrow = m < ROW_S ? args.in[I_XP] + (size_t)m * DM : (m < ROW_M ? args.in[I_XS] + (size_t)(m - ROW_S) * DM : args.in[I_META] + (size_t)(m - ROW_M) * DM);
                const f32x4* xr = (const f32x4*)xrow + lane;
                f32x4 v[8]; float s = 0.f;
#pragma unroll
                for (int jj = 0; jj < 8; ++jj) { v[jj] = xr[64 * jj]; s += (v[jj][0] * v[jj][0] + v[jj][1] * v[jj][1]) + (v[jj][2] * v[jj][2] + v[jj][3] * v[jj][3]); }
                const float rs = __builtin_amdgcn_rsqf(wave_sum(s) * (1.f / DM) + EPS);
#pragma unroll
                for (int jj = 0; jj < 8; ++jj) { const f32x4 y = v[jj] * gv[jj] * rs; o8[64 * jj] = (u32x2){cvtpk(y[0], y[1]), cvtpk(y[2], y[3])};
                    int w8 = __builtin_amdgcn_cvt_pk_fp8_f32(y[0], y[1], 0, false); w8 = __builtin_amdgcn_cvt_pk_fp8_f32(y[2], y[3], w8, true); o4[64 * jj] = (unsigned)w8; }
            }
        }
        for (int it = gw; it < 2 * 128 * 16; it += NGW) {
            const int kv = it & 1, tile = it >> 1;
            const float* src = (kv ? args.in[I_CV] : args.in[I_CK]) + (size_t)tile * 64 * 128;
            bf16_t* dst = (kv ? Vcb : Kcb) + (size_t)tile * 8192;
#pragma unroll 4
            for (int i = 0; i < 16; ++i) {
                const int p = i * 64 + lane, key = p >> 4, dc = p & 15;
                const f32x4 a = *(const f32x4*)(src + key * 128 + dc * 8), c = *(const f32x4*)(src + key * 128 + dc * 8 + 4);
                const int off = kv ? ((dc >> 2) * 2048 + (key >> 4) * 512 + (key & 15) * 32 + (dc & 3) * 8) : (dc * 512 + key * 8);
                *(u32x4*)(dst + off) = pack8(a, c);
            }
        }
        {
            const int gt = vcu * (NWAVES * 64) + tid, NGT = G * NWAVES * 64; const u32x4 z = (u32x4){0u, 0u, 0u, 0u};
            for (int i = gt; i < 2 * 8 * 1024; i += NGT) ((u32x4*)Kmb)[i] = z;
            for (int i = gt; i < 2 * 128 * 1024; i += NGT) ((u32x4*)Ksb)[i] = z;
            for (int i = gt; i < 256; i += NGT) ((u32x4*)(Qs + (size_t)128 * SS * 128))[i] = z;
            for (int i = gt; i < NB * 30 * 128; i += NGT) { const int b = i / (30 * 128), r = i % (30 * 128); ((u32x4*)(GLU + (size_t)b * GLU_PB * CC))[r] = z; }
            for (int i = gt; i < 32 * 128; i += NGT) ((u32x4*)(GLU + (size_t)(GLU_S0 + SB * GLU_SB) * CC))[i] = z;
            for (int i = gt; i < SB * 30 * 128; i += NGT) { const int b = i / (30 * 128), r = i % (30 * 128); const float* sp = args.in[I_SC] + (size_t)b * 30 * CC + r * 8;
                ((u32x4*)(GLU + (size_t)(GLU_S0 + b * GLU_SB) * CC))[r] = pack8(*(const f32x4*)sp, *(const f32x4*)(sp + 4)); }
            for (int i = gt; i < SB * 14 * CC / 4; i += NGT) { const int b = i / (14 * CC / 4), r = i % (14 * CC / 4);
                ((f32x4*)(args.out + OFF_CS + (size_t)b * 30 * CC))[r] = ((const f32x4*)(args.in[I_SC] + ((size_t)b * 30 + 16) * CC))[r]; }
        }
        if (BOTH(0)) xcd_barrier(bar);
    }

    if (IN(1)) {
        LAS unsigned* qmail = (LAS unsigned*)(lds + MISC_OFF + 64);
        const int qx = bx & 7, qslot = bx >> 3, qns = (G % 8 == 0) ? G / 8 : 0;
        { pg8::Gemm g{Hb, W1T, DM, DM, DM}; SchedIn S{{ctl + CW_GQ, qmail, qx, qslot, qns, 129 * 28 + 16}};
          EpiIn E{args.out, args.in[I_QG], args.in[I_KG], Qb, Qs, Kb, Vb, Kmb, Vmb, Ksb, Vsb, ZA, GLU, ZC, GC, GA, 0};
          pg8::gemm_phase<EpiIn, SchedIn, true, false, true>(lds, g, S, E); }
        { pg8::Gemm g{(const bf16_t*)H8, (const bf16_t*)W8, DM / 2, DM / 2, DM / 2}; SchedGate S{{ctl + CW_GQ + 512, qmail, qx, qslot, qns, 129 * 16}};
          EpiGate E{GC, GA};
          pg8::gemm_phase<EpiGate, SchedGate, true, true, true>(lds, g, S, E); }
        if (BOTH(1)) xcd_barrier(bar);
    }

    if (IN(2)) {
        float lam;
        { const float* lq = args.in[I_LQK]; const float a = wave_sum(lq[lane] * lq[64 + lane]), c = wave_sum(lq[128 + lane] * lq[192 + lane]); lam = __expf(a) - __expf(c) + 0.2f; }
        att::Tensors T{Qb, Qs, Kb, Vb, Kmb, Vmb, Ksb, Vsb, Kcb, Vcb, ZA, CA, args.in[I_RB], args.in[I_SLG]};
        for (int q = vcu; q < 2048; q += G) {
            const int i = q >> 8, v = q & 255, bh = v >> 1, p = v & 1, s = 4 * p + (i >> 1), j = (i & 1) ? 15 - s : s;
            att::attn_unit(T, 0, bh >> 3, bh & 7, j, lds, lam);
        }
        ConvT C{GLU, ZC, CA};
        LAS unsigned* qw = (LAS unsigned*)(lds + AUX_OFF + 3072);
        for (;;) {
            if (tid == 0) qw[0] = __hip_atomic_fetch_add(ctl + CW_Q, 1u, __ATOMIC_RELAXED, __HIP_MEMORY_SCOPE_AGENT);
            __syncthreads();
            const int item = (int)qw[0];
            __syncthreads();
            if (item >= 128) break;
            att::attn_unit(T, 1, item >> 3, item & 7, 0, lds, lam);
        }
        ConvW CP;
        { const int c2 = 2 * tid;
#pragma unroll
          for (int w = 0; w < CW; ++w) CP.W[w] = *(const f32x2*)(args.in[I_CWT] + w * CC + c2);
          CP.bias = *(const f32x2*)(args.in[I_CB] + c2); CP.gg = *(const f32x2*)(args.in[I_LNG] + c2); CP.bb = *(const f32x2*)(args.in[I_LNB] + c2); }
        for (;;) {
            if (tid == 0) qw[0] = __hip_atomic_fetch_add(ctl + CW_Q + 64, 1u, __ATOMIC_RELAXED, __HIP_MEMORY_SCOPE_AGENT);
            __syncthreads();
            const int item = (int)qw[0];
            __syncthreads();
            if (item >= 1024 + SB) break;
            conv_unit(C, CP, item, lds);
        }
        if (BOTH(2)) xcd_barrier(bar);
    }

    if (IN(3)) {
        for (int v = vcu; v < 256; v += G) side_p3(CA, WBT, GC, GA, MG, v);
        pg8::Gemm g{CA, WBT, DM, DM, CC}; SchedBr S{G, bx}; EpiBr E{GC, GA, MG};
        pg8::gemm_phase<EpiBr, SchedBr, true>(lds, g, S, E);
        if (BOTH(3)) xcd_barrier(bar);
    }

    if (IN(4)) {
        for (int v = vcu; v < 256; v += G) side_p4(MG, WOT, args.in[I_XS], args.out + OFF_YS, v);
        pg8::Gemm g{MG, WOT, DM, DM, DM}; SchedOut S{G, bx}; EpiOut E{args.in[I_XP], args.in[I_XS], args.out};
        pg8::gemm_phase<EpiOut, SchedOut, true>(lds, g, S, E);
    }
#undef IN
#undef BOTH
}

extern "C" void kernel_launch(void* const* d_in, const int* in_sizes, int n_in, void* d_out, int out_size, void* d_ws, size_t ws_size, hipStream_t stream) {
    static int grid = 0;
    if (grid == 0) {
        if (n_in != 19 || (size_t)out_size != OUT_TOTAL || ws_size < WS_END) { fprintf(stderr, "kernel_launch: unexpected shapes: n_in %d out %d ws %zu\n", n_in, out_size, ws_size); grid = -1; return; }
        int dev = 0, cus = 0, per_cu = 0;
        if (hipGetDevice(&dev) != hipSuccess || hipDeviceGetAttribute(&cus, hipDeviceAttributeMultiprocessorCount, dev) != hipSuccess) { grid = -1; return; }
        if (hipFuncSetAttribute((const void*)fwd_kernel, hipFuncAttributeMaxDynamicSharedMemorySize, LDS_BYTES) != hipSuccess) { fprintf(stderr, "kernel_launch: hipFuncSetAttribute failed\n"); grid = -1; return; }
        if (hipOccupancyMaxActiveBlocksPerMultiprocessor(&per_cu, (const void*)fwd_kernel, NWAVES * 64, LDS_BYTES) != hipSuccess || per_cu < 1)
            fprintf(stderr, "kernel_launch: note: occupancy query reports %d workgroups per CU\n", per_cu);
        (void)hipGetLastError();
        grid = cus;
    }
    if (grid < 0) return;
    (void)hipMemsetAsync((char*)d_ws + WS_CTL, 0, CTL_ZERO_BYTES, stream);
    Args a{};
    for (int i = 0; i < 19; ++i) a.in[i] = (const float*)d_in[i];
    a.out = (float*)d_out; a.ws = (unsigned char*)d_ws;
#ifndef PROBE_PROG
    a.ph_lo = 0; a.ph_hi = 5; a.li = 0;
    hipLaunchKernelGGL(fwd_kernel, dim3(grid), dim3(NWAVES * 64), LDS_BYTES, stream, a);
#else
    { static const int prog[] = {PROBE_PROG};
      for (int li = 0; li < (int)(sizeof(prog) / sizeof(prog[0])); ++li) { a.ph_lo = prog[li]; a.ph_hi = prog[li] + 1; a.li = li; hipLaunchKernelGGL(fwd_kernel, dim3(grid), dim3(NWAVES * 64), LDS_BYTES, stream, a); } }
#endif
}
```

```cpp
#include <hip/hip_runtime.h>
#include <cstdio>
#include <cstdint>

#define LAS __attribute__((address_space(3)))
#define GAS __attribute__((address_space(1)))
typedef unsigned short bf16_t;
typedef short bf16x8 __attribute__((ext_vector_type(8)));
typedef short s16x4 __attribute__((ext_vector_type(4)));
typedef float f32x2 __attribute__((ext_vector_type(2)));
typedef float f32x4 __attribute__((ext_vector_type(4)));
typedef float f32x16 __attribute__((ext_vector_type(16)));
typedef unsigned u32x2 __attribute__((ext_vector_type(2)));
typedef unsigned u32x4 __attribute__((ext_vector_type(4)));
typedef __bf16 bf16x2_t __attribute__((ext_vector_type(2)));

constexpr int DM = 2048, NB = 16, SEQ = 2048, NMETA = 16, LP = NMETA + SEQ, NH = 8, CC = 1024, CW = 31, DIN = 11264;
constexpr int SB = 16, SS = 16, PAST = 1024;
constexpr int ROW_S = NB * SEQ;
constexpr int ROW_M = ROW_S + SB * SS;
constexpr int MROWS = 33280;
constexpr float EPS = 1e-6f;
constexpr float LOG2E = 1.4426950408889634f;
constexpr float QSCALE = 0.125f * LOG2E;
constexpr size_t OFF_YP = 0, OFF_YS = OFF_YP + (size_t)NB * SEQ * DM, OFF_KP = OFF_YS + (size_t)SB * SS * DM, OFF_VP = OFF_KP + (size_t)NB * NH * LP * 128,
                 OFF_CP = OFF_VP + (size_t)NB * NH * LP * 128, OFF_KS = OFF_CP + (size_t)NB * 30 * CC, OFF_VS = OFF_KS + (size_t)SB * NH * SS * 128,
                 OFF_CS = OFF_VS + (size_t)SB * NH * SS * 128, OUT_TOTAL = OFF_CS + (size_t)SB * 30 * CC;
constexpr size_t MiB = 1u << 20;
constexpr size_t WS_CTL = 0, CTL_ZERO_BYTES = 1 * MiB;
constexpr size_t WS_W1T = 1 * MiB, WS_WBT = 45 * MiB, WS_WOT = 53 * MiB;
constexpr size_t WS_KMB = 61 * MiB, WS_VMB = WS_KMB + 128 * 1024, WS_KSB = 62 * MiB, WS_VSB = 64 * MiB, WS_QS = 66 * MiB;
constexpr size_t WS_H = 67 * MiB, WS_CA = 67 * MiB;
constexpr size_t WS_QB = 197 * MiB, WS_KB = 261 * MiB, WS_VB = 325 * MiB, WS_MG = 197 * MiB;
constexpr size_t WS_ZA = 389 * MiB, WS_GLU = 454 * MiB, WS_ZC = 522 * MiB, WS_GC = 587 * MiB, WS_GA = 716 * MiB;
constexpr size_t WS_KCB = 845 * MiB, WS_VCB = 877 * MiB, WS_H8 = 909 * MiB, WS_W8 = 974 * MiB, WS_END = 982 * MiB;
constexpr int GLU_PB = 30 + NMETA + SEQ, GLU_S0 = NB * GLU_PB, GLU_SB = 30 + SS, GLU_ROWS = GLU_S0 + SB * GLU_SB + 32;
constexpr int CW_BAR = 4096, CW_Q = 2048, CW_GQ = 32768;

constexpr int RING_BYTES = 131072, LDSCTL_OFF = RING_BYTES, MISC_OFF = LDSCTL_OFF + 320, AUX_OFF = RING_BYTES + 1024, LDS_BYTES = 147456;
constexpr int NWAVES = 8;

__device__ __forceinline__ unsigned cvtpk(float lo, float hi) { f32x2 v = {lo, hi}; bf16x2_t b = __builtin_convertvector(v, bf16x2_t); return __builtin_bit_cast(unsigned, b); }
__device__ __forceinline__ float bflo(unsigned w) { return __uint_as_float(w << 16); }
__device__ __forceinline__ float bfhi(unsigned w) { return __uint_as_float(w & 0xffff0000u); }
__device__ __forceinline__ float sigmoidf_(float x) { return __builtin_amdgcn_rcpf(1.f + __builtin_amdgcn_exp2f(-LOG2E * x)); }
__device__ __forceinline__ float siluf_(float x) { return x * sigmoidf_(x); }
__device__ __forceinline__ u32x4 pack8(const f32x4& a, const f32x4& b) { u32x4 w; w.x = cvtpk(a[0], a[1]); w.y = cvtpk(a[2], a[3]); w.z = cvtpk(b[0], b[1]); w.w = cvtpk(b[2], b[3]); return w; }
#define LDS_WAIT() asm volatile("s_waitcnt lgkmcnt(0)" ::: "memory")
#define VM_WAIT() asm volatile("s_waitcnt vmcnt(0)" ::: "memory")

namespace pg8 {
constexpr int BM = 256, BK = 64, HALF = 128, HTB = HALF * BK * 2, STAGE_BYTES = 8 * HTB, NXCD = 8, WGM = 4;
__host__ __device__ __forceinline__ int lds_byte(int r, int c) { const int st = (r >> 4) * 2 + (c >> 5), rr = r & 15, cc = c & 31, ob = rr * 64 + cc * 2; return st * 1024 + (ob ^ (((ob >> 9) & 1) << 5)); }
__host__ __device__ __forceinline__ void stage_rc(int b, int& R, int& C) { const int st = b / 1024, sb = b % 1024, swz = sb ^ (((sb >> 9) & 1) << 5); R = (st >> 1) * 16 + swz / 64; C = (st & 1) * 32 + (swz % 64) / 2; }
__host__ __device__ __forceinline__ int perm32(int rho) { const int n = rho >> 4, i = rho & 15; return 8 * (i >> 2) + 4 * n + (i & 3); }

struct Unit { int pm, pn, ko, aux; };
struct Gemm { const bf16_t* A; const bf16_t* Bt; int lda, ldb, K; };

__device__ __forceinline__ void tile_of(int L, int nM, int nN, int& pm, int& pn) {
    const int nwg = nM * nN; int wgid = L;
    { const int q = nwg / NXCD, r = nwg % NXCD, xcd = wgid % NXCD, off = wgid / NXCD; wgid = (xcd < r ? xcd * (q + 1) : r * (q + 1) + (xcd - r) * q) + off; }
    const int nig = WGM * nN, gid = wgid / nig, fm = gid * WGM, gsz = (nM - fm) < WGM ? (nM - fm) : WGM;
    pm = fm + ((wgid % nig) % gsz); pn = (wgid % nig) / gsz;
}

struct DynQ { unsigned* ctr; LAS unsigned* mail; int x, slot, nslot, nwg, nstat; };
__device__ __forceinline__ unsigned dq_issue(const DynQ& q, int cursor) {
    unsigned k = 0u;
    if (threadIdx.x == 0) k = __hip_atomic_fetch_add(q.ctr + 64 * cursor, 1u, __ATOMIC_RELAXED, __HIP_MEMORY_SCOPE_AGENT);
    return k;
}
__device__ __forceinline__ int dq_finish(const DynQ& q, int& cursor, unsigned k0) {
    if (threadIdx.x == 0) {
        int L = -1, y = cursor; unsigned k = k0;
        for (int tries = 0; ; ) {
            const long Lc = ((long)k + (long)q.nstat * q.nslot) * 8 + y;
            if (Lc < q.nwg) { L = (int)Lc; break; }
            if (++tries == 8) break;
            y = (y + 1) & 7; k = __hip_atomic_fetch_add(q.ctr + 64 * y, 1u, __ATOMIC_RELAXED, __HIP_MEMORY_SCOPE_AGENT);
        }
        q.mail[0] = (unsigned)L; q.mail[1] = (unsigned)y;
    }
    asm volatile("s_waitcnt lgkmcnt(0)" ::: "memory"); __builtin_amdgcn_s_barrier(); asm volatile("" ::: "memory");
    const int L = __builtin_amdgcn_readfirstlane((int)q.mail[0]); cursor = __builtin_amdgcn_readfirstlane((int)q.mail[1]);
    return L;
}

typedef int v4i32 __attribute__((ext_vector_type(4)));
typedef int v8i32 __attribute__((ext_vector_type(8)));
template <class Epi, class Sched, bool ALIGN_EPI, bool FP8 = false, bool DYN = false>
__device__ __forceinline__ void gemm_phase(LAS unsigned char* lds, const Gemm g, const Sched& S, const Epi& E) {
    const int tid = threadIdx.x, wid = __builtin_amdgcn_readfirstlane(tid >> 6), lane = tid & 63, wr = wid >> 2, wc = wid & 3, fr = lane & 15, fq = lane >> 4;
    const int nt = g.K / BK;
    unsigned voffA[2], voffB[2];
#pragma unroll
    for (int i = 0; i < 2; ++i) { int R, C; stage_rc(tid * 16 + i * 8192, R, C); const int Rb = (R & ~31) + perm32(R & 31);
        voffA[i] = (unsigned)(R * g.lda + C) * 2u; voffB[i] = (unsigned)(Rb * g.ldb + C) * 2u; }
    const size_t kstep = (size_t)(BK * 2);
    const size_t hstepA = (size_t)HALF * g.lda * 2, hstepB = (size_t)HALF * g.ldb * 2;
    const unsigned ldsw = (unsigned)wid * 1024u;
    const int fcol = FP8 ? (fq >> 1) * 32 + (fq & 1) * 16 : fq * 8;
    const int aoff = lds_byte(wr * 64 + fr, fcol), boff = lds_byte(wc * 32 + fr, fcol);
    constexpr int KOFF = FP8 ? 16 : 1024;
    int sc_w = 121, sc_a = 127; asm volatile("" : "+v"(sc_w), "+v"(sc_a));
#define PG8_SA(b, h) (((b) * 2 + (h)) * HTB)
#define PG8_SB(b, h) ((4 + (b) * 2 + (h)) * HTB)
#define PG8_STAGE(bufoff, gbase, voff) do { _Pragma("unroll") for (int _i = 0; _i < 2; ++_i) \
        __builtin_amdgcn_global_load_lds((const unsigned*)((const char*)(gbase) + (voff)[_i]), (LAS unsigned*)(lds + (bufoff) + ldsw + _i * 8192), 16, 0, 0); } while (0)
#define PG8_LDA(dst, b, h) do { _Pragma("unroll") for (int m = 0; m < 4; ++m) _Pragma("unroll") for (int k = 0; k < 2; ++k) dst[m][k] = *(const LAS bf16x8*)(lds + PG8_SA(b, h) + aoff + m * 2048 + k * KOFF); } while (0)
#define PG8_LDB(dst, b, h) do { _Pragma("unroll") for (int n = 0; n < 2; ++n) _Pragma("unroll") for (int k = 0; k < 2; ++k) dst[n][k] = *(const LAS bf16x8*)(lds + PG8_SB(b, h) + boff + n * 2048 + k * KOFF); } while (0)
#define PG8_MMA(ai, bj, At, Bt) do { __builtin_amdgcn_s_setprio(1); _Pragma("unroll") for (int m = 0; m < 4; ++m) _Pragma("unroll") for (int n = 0; n < 2; ++n) { \
        if constexpr (FP8) { \
            const v8i32 bw_ = __builtin_shufflevector(__builtin_bit_cast(v4i32, Bt[n][0]), __builtin_bit_cast(v4i32, Bt[n][1]), 0, 1, 2, 3, 4, 5, 6, 7); \
            const v8i32 aw_ = __builtin_shufflevector(__builtin_bit_cast(v4i32, At[m][0]), __builtin_bit_cast(v4i32, At[m][1]), 0, 1, 2, 3, 4, 5, 6, 7); \
            asm volatile("v_mfma_scale_f32_16x16x128_f8f6f4 %0, %1, %2, %0, %3, %4 op_sel_hi:[0,0,0]" : "+v"(acc[ai][bj][m][n]) : "v"(bw_), "v"(aw_), "v"(sc_w), "v"(sc_a)); \
        } else { _Pragma("unroll") for (int k = 0; k < 2; ++k) acc[ai][bj][m][n] = __builtin_amdgcn_mfma_f32_16x16x32_bf16(Bt[n][k], At[m][k], acc[ai][bj][m][n], 0, 0, 0); } } \
        __builtin_amdgcn_s_setprio(0); } while (0)
#define PG8_WAIT_V(n) asm volatile("s_waitcnt vmcnt(" #n ")" ::: "memory")
#define PG8_WAIT_L(n) asm volatile("s_waitcnt lgkmcnt(" #n ")" ::: "memory")
#define PG8_BAR __builtin_amdgcn_s_barrier()
#define PG8_SCHED __builtin_amdgcn_sched_barrier(0)
    Unit cur, nxt, nn; int ui = 0; bool nxt_ok = false, nn_ok = false; int dq_cur = 0; unsigned dq_k0 = 0u;
    if constexpr (DYN) {
        static_assert(ALIGN_EPI, "the dequeue broadcast needs the two half-workgroups aligned at the epilogue");
        dq_cur = S.q.x;
        if (S.q.nslot > 0) {
            if (!S.map(S.q.slot * 8 + S.q.x, cur)) return;
            nxt_ok = S.map((S.q.nslot + S.q.slot) * 8 + S.q.x, nxt);
        } else {
            const int L0 = dq_finish(S.q, dq_cur, dq_issue(S.q, dq_cur)); if (L0 < 0 || !S.map(L0, cur)) return;
            const int L1 = dq_finish(S.q, dq_cur, dq_issue(S.q, dq_cur)); nxt_ok = L1 >= 0 && S.map(L1, nxt);
        }
    } else { if (!S.next(0, cur)) return; }
    f32x4 acc[2][2][4][2];
#pragma unroll
    for (int a = 0; a < 2; ++a)
#pragma unroll
        for (int b = 0; b < 2; ++b)
#pragma unroll
            for (int m = 0; m < 4; ++m)
#pragma unroll
                for (int n = 0; n < 2; ++n) acc[a][b][m][n] = (f32x4){0.f, 0.f, 0.f, 0.f};
    bf16x8 At[4][2], B0[2][2], B1[2][2];
    const char* cA = (const char*)g.A + (size_t)cur.pm * 2 * hstepA + (size_t)cur.ko * 2; const char* cB = (const char*)g.Bt + (size_t)cur.pn * 2 * hstepB + (size_t)cur.ko * 2;
    PG8_STAGE(PG8_SB(0, 0), cB, voffB); PG8_STAGE(PG8_SB(0, 1), cB + hstepB, voffB); PG8_STAGE(PG8_SA(0, 0), cA, voffA); PG8_STAGE(PG8_SA(0, 1), cA + hstepA, voffA);
    if (wr == 1) PG8_BAR;
    PG8_WAIT_V(2); PG8_BAR;
    PG8_STAGE(PG8_SB(1, 0), cB + kstep, voffB); PG8_STAGE(PG8_SA(1, 0), cA + kstep, voffA); PG8_STAGE(PG8_SB(1, 1), cB + hstepB + kstep, voffB);
    PG8_WAIT_V(6); PG8_BAR;
    for (;;) {
        bool has_next;
        if constexpr (DYN) has_next = nxt_ok; else has_next = S.next(ui + 1, nxt);
        const char* nA = has_next ? (const char*)g.A + (size_t)nxt.pm * 2 * hstepA + (size_t)nxt.ko * 2 : cA;
        const char* nB = has_next ? (const char*)g.Bt + (size_t)nxt.pn * 2 * hstepB + (size_t)nxt.ko * 2 : cB;
        for (int t = 0; t < nt; t += 2) {
            const bool last = (t == nt - 2);
            const char* a1 = cA + (size_t)(t + 1) * kstep;
            const char* a2 = last ? nA : cA + (size_t)(t + 2) * kstep; const char* b2 = last ? nB : cB + (size_t)(t + 2) * kstep;
            const char* a3 = a2 + kstep; const char* b3 = b2 + kstep;
            PG8_LDB(B0, 0, 0); PG8_LDB(B1, 0, 1); PG8_SCHED; PG8_LDA(At, 0, 0); PG8_STAGE(PG8_SA(1, 1), a1 + hstepA, voffA);
            PG8_WAIT_V(8); PG8_WAIT_L(0); PG8_BAR; PG8_MMA(0, 0, At, B0); PG8_MMA(0, 1, At, B1); PG8_BAR; PG8_SCHED;
            PG8_LDA(At, 0, 1); PG8_STAGE(PG8_SB(0, 0), b2, voffB); PG8_STAGE(PG8_SB(0, 1), b2 + hstepB, voffB); PG8_STAGE(PG8_SA(0, 0), a2, voffA);
            PG8_WAIT_V(8); PG8_WAIT_L(0); PG8_BAR; PG8_MMA(1, 0, At, B0); PG8_MMA(1, 1, At, B1); PG8_BAR; PG8_SCHED;
            PG8_LDB(B0, 1, 0); PG8_LDB(B1, 1, 1); PG8_SCHED; PG8_LDA(At, 1, 0); PG8_STAGE(PG8_SA(0, 1), a2 + hstepA, voffA);
            PG8_WAIT_V(8); PG8_WAIT_L(0); PG8_BAR; PG8_MMA(0, 0, At, B0); PG8_MMA(0, 1, At, B1); PG8_BAR; PG8_SCHED;
            PG8_LDA(At, 1, 1); PG8_STAGE(PG8_SB(1, 0), b3, voffB); PG8_STAGE(PG8_SB(1, 1), b3 + hstepB, voffB); PG8_STAGE(PG8_SA(1, 0), a3, voffA);
            PG8_WAIT_V(8); PG8_WAIT_L(0); PG8_BAR; PG8_MMA(1, 0, At, B0); PG8_MMA(1, 1, At, B1); PG8_BAR; PG8_SCHED;
        }
        if constexpr (ALIGN_EPI) { if (wr == 0) PG8_BAR; }
        if constexpr (FP8) asm volatile("s_nop 15\n\ts_nop 7" ::: "memory");
        if constexpr (DYN) { if (has_next && ui + 2 >= S.q.nstat) dq_k0 = dq_issue(S.q, dq_cur); }
        E(acc, cur, wr, wc, fr, fq);
        if (!has_next) break;
        if constexpr (DYN) {
            if (ui + 2 < S.q.nstat) nn_ok = S.map(((ui + 2) * S.q.nslot + S.q.slot) * 8 + S.q.x, nn);
            else { const int L2 = dq_finish(S.q, dq_cur, dq_k0); nn_ok = L2 >= 0 && S.map(L2, nn); } }
#pragma unroll
        for (int a = 0; a < 2; ++a)
#pragma unroll
            for (int b = 0; b < 2; ++b)
#pragma unroll
                for (int m = 0; m < 4; ++m)
#pragma unroll
                    for (int n = 0; n < 2; ++n) acc[a][b][m][n] = (f32x4){0.f, 0.f, 0.f, 0.f};
        cur = nxt; cA = nA; cB = nB; ++ui;
        if constexpr (DYN) { nxt = nn; nxt_ok = nn_ok; }
        if constexpr (ALIGN_EPI) { if (wr == 1) PG8_BAR; }
    }
    PG8_WAIT_V(0);
    if constexpr (!ALIGN_EPI) { if (wr == 0) PG8_BAR; }
    PG8_BAR;
#undef PG8_SA
#undef PG8_SB
#undef PG8_STAGE
#undef PG8_LDA
#undef PG8_LDB
#undef PG8_MMA
#undef PG8_WAIT_V
#undef PG8_WAIT_L
#undef PG8_BAR
#undef PG8_SCHED
}
}

struct Args {
    const float* in[19];
    float* out; unsigned char* ws;
    int ph_lo, ph_hi, li, pad;
};
enum { I_XP = 0, I_XS, I_CK, I_CV, I_SC, I_META, I_RB, I_NG, I_WIN, I_QG, I_KG, I_LQK, I_SLG, I_CWT, I_CB, I_LNG, I_LNB, I_WB, I_WO };

struct SchedIn {
    pg8::DynQ q;
    __device__ __forceinline__ bool map(int L, pg8::Unit& u) const {
        constexpr int NREG = 129 * 28;
        u.ko = 0; u.aux = 0;
        if (L < NREG) { pg8::tile_of(L, 129, 28, u.pm, u.pn); return true; }
        const int e = L - NREG; if (e >= 16) return false;
        u.pm = 129; u.pn = e < 8 ? 4 + e : 8 + e; return true;
    }
    __device__ __forceinline__ bool next(int, pg8::Unit&) const { return false; }
};
struct SchedGate {
    pg8::DynQ q;
    __device__ __forceinline__ bool map(int L, pg8::Unit& u) const {
        if (L >= 129 * 16) return false;
        pg8::tile_of(L, 129, 16, u.pm, u.pn); u.ko = 0; u.aux = 0; return true;
    }
    __device__ __forceinline__ bool next(int, pg8::Unit&) const { return false; }
};

struct EpiIn {
    float* out; const float* qg; const float* kg;
    bf16_t *Qb, *Qs, *Kb, *Vb, *Kmb, *Vmb, *Ksb, *Vsb, *ZA, *GLU, *ZC, *GC, *GA; int pn_base;
    __device__ __forceinline__ void operator()(const f32x4 (&acc)[2][2][4][2], const pg8::Unit& u, int wr, int wc, int fr, int fq) const {
        asm volatile("" : "+v"(fr), "+v"(fq));
        const int pm = u.pm, pn = u.pn + pn_base;
        const int kind = pm < 128 ? 0 : (pm == 128 ? 1 : 2);
        if (pn < 8) {
            const bool isk = pn >= 4; const int head = 2 * (pn & 3) + (wc >> 1), map = wc & 1;
            const float* gp = (isk ? kg : qg) + head * 64 + 8 * fq;
            f32x4 gv[2][2];
#pragma unroll
            for (int bj = 0; bj < 2; ++bj)
#pragma unroll
                for (int n = 0; n < 2; ++n) gv[bj][n] = *(const f32x4*)(gp + 32 * bj + 4 * n);
            const float osc = isk ? 1.f : QSCALE;
#pragma unroll
            for (int ai = 0; ai < 2; ++ai)
#pragma unroll
                for (int m = 0; m < 4; ++m) {
                    float ss = 0.f;
#pragma unroll
                    for (int bj = 0; bj < 2; ++bj)
#pragma unroll
                        for (int n = 0; n < 2; ++n) { const f32x4 v = acc[ai][bj][m][n]; ss += (v[0] * v[0] + v[1] * v[1]) + (v[2] * v[2] + v[3] * v[3]); }
                    ss += __shfl_xor(ss, 16); ss += __shfl_xor(ss, 32);
                    const float rs = __builtin_amdgcn_rsqf(ss * (1.f / 64.f) + EPS) * osc;
                    f32x4 o[2][2];
#pragma unroll
                    for (int bj = 0; bj < 2; ++bj)
#pragma unroll
                        for (int n = 0; n < 2; ++n) o[bj][n] = acc[ai][bj][m][n] * gv[bj][n] * rs;
                    const int rl = ai * 128 + wr * 64 + m * 16 + fr;
                    if (kind == 0) {
                        const int b = pm >> 3, t = (pm & 7) * 256 + rl, bh = b * NH + head;
                        if (!isk) {
                            bf16_t* q = Qb + ((size_t)bh * SEQ + t) * 128 + map * 64 + 8 * fq;
#pragma unroll
                            for (int bj = 0; bj < 2; ++bj) *(u32x4*)(q + 32 * bj) = pack8(o[bj][0], o[bj][1]);
                        } else {
                            float* kf = out + OFF_KP + ((size_t)bh * LP + NMETA + t) * 128 + map * 64 + 8 * fq;
                            bf16_t* kb = Kb + ((size_t)bh * 32 + (t >> 6)) * 8192 + (map * 8 + fq) * 512 + (t & 63) * 8;
#pragma unroll
                            for (int bj = 0; bj < 2; ++bj) { *(f32x4*)(kf + 32 * bj) = o[bj][0]; *(f32x4*)(kf + 32 * bj + 4) = o[bj][1]; *(u32x4*)(kb + bj * 4 * 512) = pack8(o[bj][0], o[bj][1]); }
                        }
                    } else if (kind == 1) {
                        const int b = rl >> 4, s = rl & 15, bh = b * NH + head;
                        if (!isk) {
                            bf16_t* q = Qs + ((size_t)bh * SS + s) * 128 + map * 64 + 8 * fq;
#pragma unroll
                            for (int bj = 0; bj < 2; ++bj) *(u32x4*)(q + 32 * bj) = pack8(o[bj][0], o[bj][1]);
                        } else {
                            float* kf = out + OFF_KS + ((size_t)bh * SS + s) * 128 + map * 64 + 8 * fq;
                            bf16_t* kb = Ksb + (size_t)bh * 8192 + (map * 8 + fq) * 512 + s * 8;
#pragma unroll
                            for (int bj = 0; bj < 2; ++bj) { *(f32x4*)(kf + 32 * bj) = o[bj][0]; *(f32x4*)(kf + 32 * bj + 4) = o[bj][1]; *(u32x4*)(kb + bj * 4 * 512) = pack8(o[bj][0], o[bj][1]); }
                        }
                    } else if (isk && rl < NMETA) {
                        bf16_t* kb = Kmb + (size_t)head * 8192 + (map * 8 + fq) * 512 + rl * 8;
#pragma unroll
                        for (int bj = 0; bj < 2; ++bj) *(u32x4*)(kb + bj * 4 * 512) = pack8(o[bj][0], o[bj][1]);
                        for (int b = 0; b < NB; ++b) {
                            float* kf = out + OFF_KP + ((size_t)(b * NH + head) * LP + rl) * 128 + map * 64 + 8 * fq;
#pragma unroll
                            for (int bj = 0; bj < 2; ++bj) { *(f32x4*)(kf + 32 * bj) = o[bj][0]; *(f32x4*)(kf + 32 * bj + 4) = o[bj][1]; }
                        }
                    }
                }
        } else if (pn < 12) {
#pragma unroll
            for (int ai = 0; ai < 2; ++ai)
#pragma unroll
                for (int m = 0; m < 4; ++m) {
                    const int rl = ai * 128 + wr * 64 + m * 16 + fr;
#pragma unroll
                    for (int bj = 0; bj < 2; ++bj) {
                        const int head = 2 * (pn - 8) + bj; const f32x4 v0 = acc[ai][bj][m][0], v1 = acc[ai][bj][m][1]; const u32x4 w = pack8(v0, v1);
                        if (kind == 0) {
                            const int b = pm >> 3, t = (pm & 7) * 256 + rl, bh = b * NH + head;
                            float* vf = out + OFF_VP + ((size_t)bh * LP + NMETA + t) * 128 + 32 * wc + 8 * fq;
                            *(f32x4*)vf = v0; *(f32x4*)(vf + 4) = v1;
                            *(u32x4*)(Vb + ((size_t)bh * 32 + (t >> 6)) * 8192 + wc * 2048 + ((t >> 4) & 3) * 512 + (t & 15) * 32 + fq * 8) = w;
                        } else if (kind == 1) {
                            const int b = rl >> 4, s = rl & 15, bh = b * NH + head;
                            float* vf = out + OFF_VS + ((size_t)bh * SS + s) * 128 + 32 * wc + 8 * fq;
                            *(f32x4*)vf = v0; *(f32x4*)(vf + 4) = v1;
                            *(u32x4*)(Vsb + (size_t)bh * 8192 + wc * 2048 + s * 32 + fq * 8) = w;
                        } else if (rl < NMETA) {
                            *(u32x4*)(Vmb + (size_t)head * 8192 + wc * 2048 + rl * 32 + fq * 8) = w;
                            for (int b = 0; b < NB; ++b) { float* vf = out + OFF_VP + ((size_t)(b * NH + head) * LP + rl) * 128 + 32 * wc + 8 * fq; *(f32x4*)vf = v0; *(f32x4*)(vf + 4) = v1; }
                        }
                    }
                }
        } else if (pn >= 16 && pn < 24) {
            const int j0 = 128 * (pn - 16) + 32 * wc + 8 * fq;
#pragma unroll
            for (int ai = 0; ai < 2; ++ai)
#pragma unroll
                for (int m = 0; m < 4; ++m) {
                    const int rl = ai * 128 + wr * 64 + m * 16 + fr;
                    f32x4 o[2];
#pragma unroll
                    for (int n = 0; n < 2; ++n) { const f32x4 a = acc[ai][0][m][n], gg = acc[ai][1][m][n];
                        o[n] = (f32x4){a[0] * sigmoidf_(gg[0]), a[1] * sigmoidf_(gg[1]), a[2] * sigmoidf_(gg[2]), a[3] * sigmoidf_(gg[3])}; }
                    const u32x4 gw = pack8(o[0], o[1]);
                    if (kind == 0) {
                        const int b = pm >> 3, t = (pm & 7) * 256 + rl;
                        *(u32x4*)(GLU + ((size_t)b * GLU_PB + 30 + NMETA + t) * CC + j0) = gw;
                        if (t >= SEQ - 30) { float* cf = out + OFF_CP + ((size_t)b * 30 + (t - (SEQ - 30))) * CC + j0; *(f32x4*)cf = o[0]; *(f32x4*)(cf + 4) = o[1]; }
                    } else if (kind == 1) {
                        const int b = rl >> 4, s = rl & 15;
                        *(u32x4*)(GLU + ((size_t)GLU_S0 + b * GLU_SB + 30 + s) * CC + j0) = gw;
                        float* cf = out + OFF_CS + ((size_t)b * 30 + 14 + s) * CC + j0; *(f32x4*)cf = o[0]; *(f32x4*)(cf + 4) = o[1];
                    } else if (rl < NMETA) {
                        for (int b = 0; b < NB; ++b) *(u32x4*)(GLU + ((size_t)b * GLU_PB + 30 + rl) * CC + j0) = gw;
                    }
                }
        } else {
            if (pn < 16) act_store<true>(acc, ZA, CC, 256 * (pn - 12) + 32 * wc + 8 * fq, pm * 256 + wr * 64 + fr);
            else if (pn < 28) act_store<true>(acc, ZC, CC, 256 * (pn - 24) + 32 * wc + 8 * fq, pm * 256 + wr * 64 + fr);
            else if (pn < 36) act_store<false>(acc, GC, DM, 256 * (pn - 28) + 32 * wc + 8 * fq, pm * 256 + wr * 64 + fr);
            else act_store<false>(acc, GA, DM, 256 * (pn - 36) + 32 * wc + 8 * fq, pm * 256 + wr * 64 + fr);
        }
    }
    template <bool SIL> static __device__ __forceinline__ void act_store(const f32x4 (&acc)[2][2][4][2], bf16_t* base, int ld, int c0, int row0) {
#pragma unroll
        for (int ai = 0; ai < 2; ++ai)
#pragma unroll
            for (int m = 0; m < 4; ++m) {
                const int row = row0 + ai * 128 + m * 16;
#pragma unroll
                for (int bj = 0; bj < 2; ++bj) {
                    f32x4 o[2];
#pragma unroll
                    for (int n = 0; n < 2; ++n) { const f32x4 v = acc[ai][bj][m][n]; const f32x4 sg = (f32x4){sigmoidf_(v[0]), sigmoidf_(v[1]), sigmoidf_(v[2]), sigmoidf_(v[3])}; o[n] = SIL ? v * sg : sg; }
                    *(u32x4*)(base + (size_t)row * ld + c0 + 128 * bj) = pack8(o[0], o[1]);
                }
            }
    }
};

struct EpiGate {
    bf16_t *GC, *GA;
    __device__ __forceinline__ void operator()(const f32x4 (&acc)[2][2][4][2], const pg8::Unit& u, int wr, int wc, int fr, int fq) const {
        asm volatile("" : "+v"(fr), "+v"(fq));
        bf16_t* base = (u.pn < 8 ? GC : GA) + (size_t)(u.pm * 256 + wr * 64 + fr) * DM + 256 * (u.pn & 7) + 32 * wc + 8 * fq;
#pragma unroll
        for (int ai = 0; ai < 2; ++ai)
#pragma unroll
            for (int m = 0; m < 4; ++m)
#pragma unroll
                for (int bj = 0; bj < 2; ++bj) {
                    f32x4 o[2];
#pragma unroll
                    for (int n = 0; n < 2; ++n) { const f32x4 v = acc[ai][bj][m][n]; o[n] = (f32x4){sigmoidf_(v[0]), sigmoidf_(v[1]), sigmoidf_(v[2]), sigmoidf_(v[3])}; }
                    *(u32x4*)(base + (size_t)(ai * 128 + m * 16) * DM + 128 * bj) = pack8(o[0], o[1]);
                }
    }
};

struct SchedBr {
    int G, c;
    __device__ __forceinline__ bool next(int i, pg8::Unit& u) const {
        const int L = (i >> 1) * G + c; if (L >= 128 * 8) return false;
        pg8::tile_of(L, 128, 8, u.pm, u.pn); u.aux = i & 1; u.ko = (i & 1) * CC; return true;
    }
};
struct EpiBr {
    const bf16_t* GC; const bf16_t* GA; bf16_t* MG;
    __device__ __forceinline__ void operator()(const f32x4 (&acc)[2][2][4][2], const pg8::Unit& u, int wr, int wc, int fr, int fq) const {
        asm volatile("" : "+v"(fr), "+v"(fq));
        const bf16_t* gate = u.aux ? GA : GC;
        const size_t base = ((size_t)u.pm * 256 + wr * 64 + fr) * DM + u.pn * 256 + wc * 32 + 8 * fq;
#pragma unroll
        for (int ai = 0; ai < 2; ++ai) {
            u32x4 gw[4][2], pw[4][2];
#pragma unroll
            for (int m = 0; m < 4; ++m)
#pragma unroll
                for (int bj = 0; bj < 2; ++bj) { const size_t off = base + (size_t)(ai * 128 + m * 16) * DM + bj * 128; gw[m][bj] = *(const u32x4*)(gate + off); if (u.aux) pw[m][bj] = *(const u32x4*)(MG + off); }
            __builtin_amdgcn_sched_barrier(0);
#pragma unroll
            for (int m = 0; m < 4; ++m)
#pragma unroll
                for (int bj = 0; bj < 2; ++bj) {
                    const size_t off = base + (size_t)(ai * 128 + m * 16) * DM + bj * 128;
                    const u32x4 g = gw[m][bj]; const f32x4 a0 = acc[ai][bj][m][0], a1 = acc[ai][bj][m][1];
                    f32x4 o0 = (f32x4){bflo(g.x) * a0[0], bfhi(g.x) * a0[1], bflo(g.y) * a0[2], bfhi(g.y) * a0[3]};
                    f32x4 o1 = (f32x4){bflo(g.z) * a1[0], bfhi(g.z) * a1[1], bflo(g.w) * a1[2], bfhi(g.w) * a1[3]};
                    if (u.aux) { const u32x4 p = pw[m][bj]; o0 += (f32x4){bflo(p.x), bfhi(p.x), bflo(p.y), bfhi(p.y)}; o1 += (f32x4){bflo(p.z), bfhi(p.z), bflo(p.w), bfhi(p.w)}; }
                    *(u32x4*)(MG + off) = pack8(o0, o1);
                }
            __builtin_amdgcn_sched_barrier(0);
        }
    }
};
struct SchedOut {
    int G, c;
    __device__ __forceinline__ bool next(int i, pg8::Unit& u) const {
        const int L = i * G + c; if (L >= 128 * 8) return false;
        pg8::tile_of(L, 128, 8, u.pm, u.pn); u.aux = 0; u.ko = 0; return true;
    }
};
struct EpiOut {
    const float* xp; const float* xs; float* out;
    __device__ __forceinline__ void operator()(const f32x4 (&acc)[2][2][4][2], const pg8::Unit& u, int wr, int wc, int fr, int fq) const {
        asm volatile("" : "+v"(fr), "+v"(fq));
        const float* src; float* dst;
        if (u.pm < 128) { src = xp + (size_t)u.pm * 256 * DM; dst = out + OFF_YP + (size_t)u.pm * 256 * DM; }
        else { src = xs; dst = out + OFF_YS; }
        const size_t base = (size_t)(wr * 64 + fr) * DM + u.pn * 256 + wc * 32 + 8 * fq;
#pragma unroll
        for (int ai = 0; ai < 2; ++ai) {
            f32x4 xv[4][2][2];
#pragma unroll
            for (int m = 0; m < 4; ++m)
#pragma unroll
                for (int bj = 0; bj < 2; ++bj)
#pragma unroll
                    for (int n = 0; n < 2; ++n) xv[m][bj][n] = *(const f32x4*)(src + base + (size_t)(ai * 128 + m * 16) * DM + bj * 128 + 4 * n);
            __builtin_amdgcn_sched_barrier(0);
#pragma unroll
            for (int m = 0; m < 4; ++m)
#pragma unroll
                for (int bj = 0; bj < 2; ++bj)
#pragma unroll
                    for (int n = 0; n < 2; ++n) *(f32x4*)(dst + base + (size_t)(ai * 128 + m * 16) * DM + bj * 128 + 4 * n) = xv[m][bj][n] + acc[ai][bj][m][n];
            __builtin_amdgcn_sched_barrier(0);
        }
    }
};

#define XB_TMO      128
#define XB_XCNT(j)  (256  + 64 * (j))
#define XB_XSUB(j)  (1280 + 64 * (j))
#define XB_XGEN(j)  (2304 + 64 * (j))
#define XB_TOP      3328
#define XB_TOPGEN   3392
#define XCD_BAR_WORDS 3456
#define XB_SPIN_CAP (1u << 18)
__device__ __forceinline__ unsigned xb_ld(unsigned* p)              { return __hip_atomic_load(p, __ATOMIC_RELAXED, __HIP_MEMORY_SCOPE_AGENT); }
__device__ __forceinline__ unsigned xb_add(unsigned* p, unsigned v) { return __hip_atomic_fetch_add(p, v, __ATOMIC_RELAXED, __HIP_MEMORY_SCOPE_AGENT); }
__device__ __forceinline__ unsigned xb_xcc_id() { return (unsigned)__builtin_amdgcn_s_getreg((3 << 11) | 20) & 0xFu; }
#define XB_SPIN(cond, bar) do { unsigned _sp = 0; while (cond) { __builtin_amdgcn_s_sleep(1); \
    if ((++_sp & 255u) == 0u) { if (xb_ld(&(bar)[XB_TMO])) break; if (_sp > XB_SPIN_CAP) { atomicAdd(&(bar)[XB_TMO], 1u); break; } } } } while (0)
struct XcdBarrier { unsigned* bar; unsigned x; volatile LAS unsigned* st; };
__device__ __forceinline__ XcdBarrier xcd_barrier_post(unsigned* bar, volatile LAS unsigned* st) {
    XcdBarrier b; b.bar = bar; b.x = xb_xcc_id(); b.st = st;
    if (threadIdx.x == 0) (void)xb_add(&bar[XB_XCNT(b.x)], 1u);
    return b;
}
__device__ __forceinline__ void xcd_barrier_complete(unsigned* bar, unsigned x, unsigned& nloc, unsigned& nx) {
    const unsigned G = gridDim.x * gridDim.y * gridDim.z;
    unsigned sum, cnt, mine, sp = 0u;
    for (;;) {
        sum = 0u; cnt = 0u; mine = 0u;
#pragma unroll
        for (unsigned j = 0; j < 16; ++j) { const unsigned c = xb_ld(&bar[XB_XCNT(j)]); sum += c; cnt += (c > 0u) ? 1u : 0u; mine = (j == x) ? c : mine; }
        if (sum == G) break;
        __builtin_amdgcn_s_sleep(1);
        if ((++sp & 255u) == 0u) { if (xb_ld(&bar[XB_TMO])) break; if (sp > XB_SPIN_CAP) { atomicAdd(&bar[XB_TMO], 1u); break; } }
    }
    nloc = mine > 0u ? mine : 1u; nx = cnt > 0u ? cnt : 1u;
}
__device__ __forceinline__ void xcd_barrier(const XcdBarrier& b) {
    asm volatile("s_waitcnt vmcnt(0)" ::: "memory");
    __syncthreads();
    if (threadIdx.x == 0) {
        unsigned* bar = b.bar;
        __builtin_amdgcn_s_waitcnt(0);
        unsigned nloc = b.st[0], nx = b.st[1];
        if (nloc == 0u) { xcd_barrier_complete(bar, b.x, nloc, nx); b.st[0] = nloc; b.st[1] = nx; }
        const unsigned old = xb_add(&bar[XB_XSUB(b.x)], 1u);
        const unsigned gen = old / nloc;
        if (old + 1u == (gen + 1u) * nloc) {
            __builtin_amdgcn_fence(__ATOMIC_RELEASE, "agent");
            asm volatile("s_waitcnt vmcnt(0)" ::: "memory");
            const unsigned og = xb_add(&bar[XB_TOP], 1u);
            const unsigned tg = og / nx;
            if (og + 1u == (tg + 1u) * nx) xb_add(&bar[XB_TOPGEN], 1u);
            else XB_SPIN(xb_ld(&bar[XB_TOPGEN]) == tg, bar);
            __builtin_amdgcn_fence(__ATOMIC_ACQUIRE, "agent");
            xb_add(&bar[XB_XGEN(b.x)], 1u);
            asm volatile("s_waitcnt vmcnt(0)" ::: "memory");
        } else {
            XB_SPIN(xb_ld(&bar[XB_XGEN(b.x)]) == gen, bar);
            __builtin_amdgcn_fence(__ATOMIC_ACQUIRE, "agent");
            asm volatile("s_waitcnt vmcnt(0)" ::: "memory");
        }
    }
    __syncthreads();
}

__device__ __forceinline__ float wave_sum(float v) {
#pragma unroll
    for (int o = 1; o < 64; o <<= 1) v += __shfl_xor(v, o);
    return v;
}
template <bool F8>
__device__ __forceinline__ void p0_transpose_item(const float* W, int N, bf16_t* WT, int ldt, int drow0, int drow1, int dcol, LAS float* scr, int k0, int n0, int lane, float wsc = 1.f) {
    f32x4 wv[8];
#pragma unroll
    for (int i = 0; i < 8; ++i) wv[i] = *(const f32x4*)(W + (size_t)(k0 + 4 * i + (lane >> 4)) * N + n0 + 4 * (lane & 15));
#pragma unroll
    for (int i = 0; i < 8; ++i) { LAS float* d = scr + (4 * i + (lane >> 4)) * 65 + 4 * (lane & 15); d[0] = wv[i][0]; d[1] = wv[i][1]; d[2] = wv[i][2]; d[3] = wv[i][3]; }
    LDS_WAIT(); asm volatile("" ::: "memory");
    const int c = lane & 3;
#pragma unroll
    for (int j = 0; j < 4; ++j) { const int n = (lane >> 2) + 16 * j; const LAS float* s = scr + (8 * c) * 65 + n;
        const int drow = (n < 32 ? drow0 : drow1) + (n & 31);
        if constexpr (F8) {
            int w0 = __builtin_amdgcn_cvt_pk_fp8_f32(s[0 * 65] * 64.f, s[1 * 65] * 64.f, 0, false); w0 = __builtin_amdgcn_cvt_pk_fp8_f32(s[2 * 65] * 64.f, s[3 * 65] * 64.f, w0, true);
            int w1 = __builtin_amdgcn_cvt_pk_fp8_f32(s[4 * 65] * 64.f, s[5 * 65] * 64.f, 0, false); w1 = __builtin_amdgcn_cvt_pk_fp8_f32(s[6 * 65] * 64.f, s[7 * 65] * 64.f, w1, true);
            *(u32x2*)((unsigned char*)WT + (size_t)drow * ldt + dcol + k0 + 8 * c) = (u32x2){(unsigned)w0, (unsigned)w1};
        } else {
            u32x4 o; o.x = cvtpk(s[0 * 65] * wsc, s[1 * 65] * wsc); o.y = cvtpk(s[2 * 65] * wsc, s[3 * 65] * wsc); o.z = cvtpk(s[4 * 65] * wsc, s[5 * 65] * wsc); o.w = cvtpk(s[6 * 65] * wsc, s[7 * 65] * wsc);
            *(u32x4*)(WT + (size_t)drow * ldt + dcol + k0 + 8 * c) = o; } }
    LDS_WAIT(); asm volatile("" ::: "memory");
}
__device__ __forceinline__ int w1_dst_row(int sb) {
    if (sb < 64) { const int region = sb >> 4, head = (sb & 15) >> 1, eh = sb & 1, qk = region >> 1, map = region & 1;
        return 256 * (qk * 4 + (head >> 1)) + eh * 128 + 32 * ((head & 1) * 2 + map); }
    if (sb < 128) return 256 * 8 + (sb - 64) * 32;
    if (sb < 160) { const int idx = sb - 128; return 256 * (16 + (idx >> 2)) + 32 * (idx & 3); }
    if (sb < 192) { const int idx = sb - 160; return 256 * (16 + (idx >> 2)) + 128 + 32 * (idx & 3); }
    return 256 * 24 + (sb - 192) * 32;
}

namespace att {
constexpr int SLOT = 16384;
constexpr int LDS_X = 0;
constexpr int AUX_WSF = AUX_OFF, AUX_LUT = AUX_OFF + 2048;
constexpr float THR = 8.f;
__device__ __forceinline__ int crow(int r, int hi) { return (r & 3) + 8 * (r >> 2) + 4 * hi; }
__device__ __forceinline__ void glds16(const void* gsrc, unsigned lds_dst) { unsigned keep;
    asm volatile("s_mov_b32 %0, m0\n\ts_mov_b32 m0, %2\n\ts_nop 0\n\tglobal_load_lds_dwordx4 %1, off\n\ts_mov_b32 m0, %0" : "=&s"(keep) : "v"(gsrc), "s"(lds_dst) : "memory"); }
template <int N> __device__ __forceinline__ float dpp_ror(float v) { return __uint_as_float(__builtin_amdgcn_update_dpp(0u, __float_as_uint(v), 0x120 + N, 0xf, 0xf, false)); }
__device__ __forceinline__ float max3f(float a, float b, float c) { float r; asm("v_max3_f32 %0, %1, %2, %3" : "=v"(r) : "v"(a), "v"(b), "v"(c)); return r; }
#define SBAR() __builtin_amdgcn_sched_barrier(0)
__device__ __forceinline__ s16x4 vtr(const LAS unsigned char* p) { return __builtin_bit_cast(s16x4, __builtin_amdgcn_ds_read_tr16_b64_v4i16((LAS s16x4*)p)); }

struct Tensors {
    const bf16_t *Qb, *Qs, *Kb, *Vb, *Kmb, *Vmb, *Ksb, *Vsb, *Kcb, *Vcb, *ZA; bf16_t* CA;
    const float* rel_bias; const float* slg;
};

__device__ __forceinline__ void attn_unit(const Tensors& T, const int sample, const int b, const int h, const int j, LAS unsigned char* lds, const float lam) {
    const int tid = threadIdx.x, lane = tid & 63, r32 = lane & 31, hi = lane >> 5;
    const int wid = __builtin_amdgcn_readfirstlane(tid >> 6), map = wid >> 2, g = wid & 3;
    const int bh = b * NH + h;
    LAS float* wsf = (LAS float*)(lds + AUX_WSF) + wid * 64;
    LAS float* lut = (LAS float*)(lds + AUX_LUT);
    if (tid < 192) {
        const int rel = tid - 128, n = rel < 0 ? -rel : rel;
        const int bk = n < 8 ? n : min(15, 2 + (31 - __clz(n * n)));
        const int bucket = (rel > 0 ? 16 : 0) + bk;
        lut[tid] = (T.rel_bias[bucket * NH + h] - T.rel_bias[15 * NH + h]) * LOG2E;
    }
    const int NT = sample ? 17 : 2 * j + 3;
    const bool act_all = sample ? (g == 0) : true;
    const bool act_last = sample ? (g == 0) : (g >= 2);
    const int qpos0 = sample ? PAST : NMETA + 128 * j + 32 * g;
    bf16x8 qr[4];
    {
        const bf16_t* qp = sample ? T.Qs + ((size_t)bh * SS + r32) * 128 : T.Qb + ((size_t)bh * SEQ + 128 * j + 32 * g + r32) * 128;
        qp += map * 64 + hi * 8;
#pragma unroll
        for (int d0 = 0; d0 < 4; ++d0) qr[d0] = *(const bf16x8*)(qp + d0 * 16);
    }
    f32x16 o[4]; o[0] = f32x16{}; o[1] = f32x16{}; o[2] = f32x16{}; o[3] = f32x16{};
    f32x16 ol = f32x16{};
    const f32x16 zero16 = f32x16{};
    const bf16x8 ones8 = (bf16x8){0x3F80, 0x3F80, 0x3F80, 0x3F80, 0x3F80, 0x3F80, 0x3F80, 0x3F80};
    auto tile_k = [&](int it) -> const bf16_t* {
        if (sample) return it < 16 ? T.Kcb + ((size_t)bh * 16 + it) * 8192 : T.Ksb + (size_t)bh * 8192;
        return it == 0 ? T.Kmb + (size_t)h * 8192 : T.Kb + ((size_t)bh * 32 + (it - 1)) * 8192;
    };
    auto tile_v = [&](int it) -> const bf16_t* {
        if (sample) return it < 16 ? T.Vcb + ((size_t)bh * 16 + it) * 8192 : T.Vsb + (size_t)bh * 8192;
        return it == 0 ? T.Vmb + (size_t)h * 8192 : T.Vb + ((size_t)bh * 32 + (it - 1)) * 8192;
    };
#define ATT_DMA(t, slot) do { const bf16_t* kp_ = tile_k(t); const bf16_t* vp_ = tile_v(t); \
        _Pragma("unroll") for (int i_ = 0; i_ < 2; ++i_) { \
            glds16(kp_ + (2 * wid + i_) * 512 + lane * 8, (unsigned)__builtin_amdgcn_readfirstlane(lds0 + (slot) * 32768 + (2 * wid + i_) * 1024)); \
            glds16(vp_ + (2 * wid + i_) * 512 + lane * 8, (unsigned)__builtin_amdgcn_readfirstlane(lds0 + (slot) * 32768 + SLOT + (2 * wid + i_) * 1024)); } } while (0)
    const unsigned lds0 = (unsigned)(uintptr_t)lds;
    asm volatile("s_waitcnt vmcnt(0)" :: "v"(qr[0]), "v"(qr[1]), "v"(qr[2]), "v"(qr[3]) : "memory");
    ATT_DMA(0, 0); ATT_DMA(1, 1); ATT_DMA(2, 2);
    const int vlane = ((lane >> 4) & 1) * 32 + (lane & 3) * 8 + (4 * hi + ((lane & 15) >> 2)) * 64;
    for (int it = 0; it < NT; ++it) {
        const int so = (it & 3) * 32768;
        asm volatile("s_waitcnt vmcnt(8)" ::: "memory"); __builtin_amdgcn_s_barrier(); asm volatile("" ::: "memory");
        { const int tn = it + 3 < NT ? it + 3 : 0; ATT_DMA(tn, (it + 3) & 3); }
        const bool active = (it == NT - 1) ? act_last : act_all;
        if (active) {
            int kpos0, nvalid;
            if (sample) { kpos0 = 64 * it; nvalid = it < 16 ? 64 : 16; } else { kpos0 = it == 0 ? 0 : NMETA + 64 * (it - 1); nvalid = it == 0 ? 16 : 64; }
            f32x16 p0, p1;
            { const LAS unsigned char* kb = lds + so + map * 8192 + hi * 1024 + r32 * 16;
              bf16x8 kf[8];
#pragma unroll
              for (int d0 = 0; d0 < 4; ++d0) { kf[2 * d0] = *(const LAS bf16x8*)(kb + d0 * 2048); kf[2 * d0 + 1] = *(const LAS bf16x8*)(kb + d0 * 2048 + 512); }
              SBAR();
              p0 = __builtin_amdgcn_mfma_f32_32x32x16_bf16(kf[0], qr[0], zero16, 0, 0, 0); p1 = __builtin_amdgcn_mfma_f32_32x32x16_bf16(kf[1], qr[0], zero16, 0, 0, 0);
#pragma unroll
              for (int d0 = 1; d0 < 4; ++d0) { p0 = __builtin_amdgcn_mfma_f32_32x32x16_bf16(kf[2 * d0], qr[d0], p0, 0, 0, 0); p1 = __builtin_amdgcn_mfma_f32_32x32x16_bf16(kf[2 * d0 + 1], qr[d0], p1, 0, 0, 0); } }
            SBAR();
            const LAS unsigned char* vb = lds + so + SLOT + vlane;
            s16x4 va[8], vbb[8];
#define ATT_VRD(dst, db) do { _Pragma("unroll") for (int s_ = 0; s_ < 4; ++s_) { dst[2 * s_] = vtr(vb + (db) * 4096 + s_ * 1024); dst[2 * s_ + 1] = vtr(vb + (db) * 4096 + s_ * 1024 + 512); } } while (0)
#define ATT_VF(src, s_) ((bf16x8){src[2 * (s_)][0], src[2 * (s_)][1], src[2 * (s_)][2], src[2 * (s_)][3], src[2 * (s_) + 1][0], src[2 * (s_) + 1][1], src[2 * (s_) + 1][2], src[2 * (s_) + 1][3]})
            ATT_VRD(va, 0);
            SBAR();
            if (kpos0 + 63 - qpos0 > -128) {
                const int rb = kpos0 - (qpos0 + r32) + 128 + 4 * hi;
#pragma unroll
                for (int r = 0; r < 16; ++r) { const int i0 = rb + (r & 3) + 8 * (r >> 2); const int i1 = i0 + 32;
                    p0[r] += lut[min(max(i0, 0), 191)]; p1[r] += lut[min(max(i1, 0), 191)]; }
            }
            if (nvalid < 64) {
#pragma unroll
                for (int r = 0; r < 16; ++r) { if ((r & 3) + 8 * (r >> 2) + 4 * hi >= nvalid) p0[r] = -INFINITY; p1[r] = -INFINITY; }
            }
#pragma unroll
            for (int r = 0; r < 16; ++r) { p0[r] = __builtin_amdgcn_exp2f(p0[r]); p1[r] = __builtin_amdgcn_exp2f(p1[r]); }
            bf16x8 pa[4];
            { u32x4 w;
              w.x = cvtpk(p0[0], p0[1]); w.y = cvtpk(p0[2], p0[3]); w.z = cvtpk(p0[4], p0[5]); w.w = cvtpk(p0[6], p0[7]); pa[0] = __builtin_bit_cast(bf16x8, w);
              w.x = cvtpk(p0[8], p0[9]); w.y = cvtpk(p0[10], p0[11]); w.z = cvtpk(p0[12], p0[13]); w.w = cvtpk(p0[14], p0[15]); pa[1] = __builtin_bit_cast(bf16x8, w);
              w.x = cvtpk(p1[0], p1[1]); w.y = cvtpk(p1[2], p1[3]); w.z = cvtpk(p1[4], p1[5]); w.w = cvtpk(p1[6], p1[7]); pa[2] = __builtin_bit_cast(bf16x8, w);
              w.x = cvtpk(p1[8], p1[9]); w.y = cvtpk(p1[10], p1[11]); w.z = cvtpk(p1[12], p1[13]); w.w = cvtpk(p1[14], p1[15]); pa[3] = __builtin_bit_cast(bf16x8, w); }
            SBAR();
#pragma unroll
            for (int s_ = 0; s_ < 4; ++s_) ol = __builtin_amdgcn_mfma_f32_32x32x16_bf16(pa[s_], ones8, ol, 0, 0, 0);
#define ATT_PV(db, cur) do { _Pragma("unroll") for (int s_ = 0; s_ < 4; ++s_) o[db] = __builtin_amdgcn_mfma_f32_32x32x16_bf16(pa[s_], ATT_VF(cur, s_), o[db], 0, 0, 0); } while (0)
            ATT_VRD(vbb, 1); SBAR(); ATT_PV(0, va); SBAR();
            ATT_VRD(va, 2);  SBAR(); ATT_PV(1, vbb); SBAR();
            ATT_VRD(vbb, 3); SBAR(); ATT_PV(2, va); SBAR();
            ATT_PV(3, vbb); SBAR();
#undef ATT_VRD
#undef ATT_VF
#undef ATT_PV
        }
    }
    asm volatile("s_waitcnt vmcnt(0) lgkmcnt(0)" ::: "memory");
    __syncthreads();
    const bool fin = sample ? (g == 0) : true;
    LAS float* xr = (LAS float*)(lds + LDS_X + g * 16384);
    const int ch = lane & 15;
    const int nq = sample ? 16 : 32;
    const size_t row0 = sample ? (size_t)ROW_S + b * SS : (size_t)b * SEQ + 128 * j + 32 * g;
    u32x4 zv[8];
    if (fin && map == 0) {
#pragma unroll
        for (int i = 0; i < 8; ++i) { const int q = min(i * 4 + (lane >> 4), nq - 1); zv[i] = *(const u32x4*)(T.ZA + (row0 + q) * CC + h * 128 + ch * 8); }
    }
    if (fin && map == 1) {
        const float sc = -lam;
#pragma unroll
        for (int r = 0; r < 16; ++r) { const float rl = __builtin_amdgcn_rcpf(ol[r]) * sc;
#pragma unroll
            for (int db = 0; db < 4; ++db) xr[(db * 16 + r) * 64 + lane] = o[db][r] * rl; }
    }
    LDS_WAIT();
    __syncthreads();
    if (fin && map == 0) {
        float ssq[16];
#pragma unroll
        for (int r = 0; r < 16; ++r) { const float rl = __builtin_amdgcn_rcpf(ol[r]); float s2 = 0.f;
#pragma unroll
            for (int db = 0; db < 4; ++db) { const float v = o[db][r] * rl + xr[(db * 16 + r) * 64 + lane]; o[db][r] = v; s2 += v * v; }
            ssq[r] = s2; }
#pragma unroll
        for (int r = 0; r < 16; ++r) { float s2 = ssq[r];
            s2 += dpp_ror<8>(s2); s2 += dpp_ror<4>(s2); s2 += dpp_ror<2>(s2); s2 += dpp_ror<1>(s2);
            { auto rr = __builtin_amdgcn_permlane16_swap(__float_as_uint(s2), __float_as_uint(s2), false, false); s2 = __uint_as_float(rr[0]) + __uint_as_float(rr[1]); }
            ssq[r] = __builtin_amdgcn_rsqf(s2 * (1.f / 128.f) + EPS) * 0.8f; }
        LDS_WAIT();
        LAS bf16_t* stg = (LAS bf16_t*)xr;
#pragma unroll
        for (int r = 0; r < 16; ++r) { const int q = crow(r, hi);
#pragma unroll
            for (int db = 0; db < 4; ++db) stg[q * 136 + db * 32 + r32] = (bf16_t)(cvtpk(o[db][r] * ssq[r], 0.f) & 0xffffu); }
        LDS_WAIT();
        const f32x4 g0 = *(const f32x4*)(T.slg + ch * 8), g1 = *(const f32x4*)(T.slg + ch * 8 + 4);
#pragma unroll
        for (int i = 0; i < 8; ++i) {
            const int q = i * 4 + (lane >> 4);
            if (q < nq) {
                const u32x4 w = *(const LAS u32x4*)(stg + q * 136 + ch * 8);
                const u32x4 z = zv[i];
                u32x4 ow;
                ow.x = cvtpk(bflo(w.x) * g0[0] * bflo(z.x), bfhi(w.x) * g0[1] * bfhi(z.x)); ow.y = cvtpk(bflo(w.y) * g0[2] * bflo(z.y), bfhi(w.y) * g0[3] * bfhi(z.y));
                ow.z = cvtpk(bflo(w.z) * g1[0] * bflo(z.z), bfhi(w.z) * g1[1] * bfhi(z.z)); ow.w = cvtpk(bflo(w.w) * g1[2] * bflo(z.w), bfhi(w.w) * g1[3] * bfhi(z.w));
                *(u32x4*)(T.CA + (row0 + q) * DM + CC + h * 128 + ch * 8) = ow;
            }
        }
    }
    LDS_WAIT();
    __syncthreads();
}
}

struct ConvT { const bf16_t *GLU, *ZC; bf16_t* CA; };
struct ConvW { f32x2 W[CW]; f32x2 bias, gg, bb; };
__device__ __forceinline__ void conv_unit(const ConvT& T, const ConvW& P, int cu, LAS unsigned char* lds) {
    const int tid = threadIdx.x, lane = tid & 63, wid = __builtin_amdgcn_readfirstlane(tid >> 6);
    const int c2 = 2 * tid;
    const bool sample = cu >= 1024;
    const int b = sample ? cu - 1024 : cu >> 6, t0 = sample ? 0 : (cu & 63) * 32;
    const bf16_t* gin = T.GLU + (sample ? (size_t)GLU_S0 + b * GLU_SB : (size_t)b * GLU_PB + NMETA + t0) * CC + c2;
    const f32x2 (&W)[CW] = P.W; const f32x2 bias = P.bias;
    f32x2 acc[32];
#pragma unroll
    for (int o = 0; o < 32; ++o) acc[o] = bias;
    unsigned wa[16], wb[16];
#define CONV_LOAD(dst, i0) do { _Pragma("unroll") for (int k = 0; k < 16; ++k) if ((i0) + k < 62) dst[k] = *(const unsigned*)(gin + (size_t)((i0) + k) * CC); } while (0)
#define CONV_FMA(src, i0) do { _Pragma("unroll") for (int k = 0; k < 16; ++k) { const int i = (i0) + k; if (i < 62) { const f32x2 v = (f32x2){bflo(src[k]), bfhi(src[k])}; \
        _Pragma("unroll") for (int o = 0; o < 32; ++o) { const int w = i - o; if (w >= 0 && w < CW) acc[o] += v * W[w]; } } } } while (0)
    CONV_LOAD(wa, 0); CONV_LOAD(wb, 16);
    __builtin_amdgcn_sched_barrier(0);
    CONV_FMA(wa, 0);
    __builtin_amdgcn_sched_barrier(0);
    CONV_LOAD(wa, 32);
    __builtin_amdgcn_sched_barrier(0);
    CONV_FMA(wb, 16);
    __builtin_amdgcn_sched_barrier(0);
    CONV_LOAD(wb, 48);
    __builtin_amdgcn_sched_barrier(0);
    CONV_FMA(wa, 32);
    __builtin_amdgcn_sched_barrier(0);
    CONV_FMA(wb, 48);
#undef CONV_LOAD
#undef CONV_FMA
    const int nout = sample ? 16 : 32;
    const size_t row0 = sample ? (size_t)ROW_S + b * SS : (size_t)b * SEQ + t0;
    float s1[32], s2[32];
#pragma unroll
    for (int o = 0; o < 32; ++o) { s1[o] = acc[o].x + acc[o].y; s2[o] = acc[o].x * acc[o].x + acc[o].y * acc[o].y; }
#pragma unroll
    for (int step = 0; step < 5; ++step) {
        const int half = 16 >> step, bit = 32 >> step; const bool up = (lane & bit) != 0;
#pragma unroll
        for (int k = 0; k < half; ++k) {
            const float send1 = up ? s1[k] : s1[k + half], keep1 = up ? s1[k + half] : s1[k];
            const float send2 = up ? s2[k] : s2[k + half], keep2 = up ? s2[k + half] : s2[k];
            s1[k] = keep1 + __shfl_xor(send1, bit); s2[k] = keep2 + __shfl_xor(send2, bit);
        }
    }
    s1[0] += __shfl_xor(s1[0], 1); s2[0] += __shfl_xor(s2[0], 1);
    LAS float* red = (LAS float*)(lds);
    LAS float* stat = (LAS float*)(lds + 2048);
    if ((lane & 1) == 0) { red[(wid * 32 + (lane >> 1)) * 2] = s1[0]; red[(wid * 32 + (lane >> 1)) * 2 + 1] = s2[0]; }
    LDS_WAIT();
    __syncthreads();
    if (tid < 32) { float a = 0.f, q = 0.f;
#pragma unroll
        for (int w = 0; w < 8; ++w) { a += red[(w * 32 + tid) * 2]; q += red[(w * 32 + tid) * 2 + 1]; }
        const float mean = a * (1.f / CC); const float var = fmaxf(q * (1.f / CC) - mean * mean, 0.f);
        stat[tid * 2] = mean; stat[tid * 2 + 1] = __builtin_amdgcn_rsqf(var + EPS); }
    LDS_WAIT();
    __syncthreads();
    const f32x2 gg = P.gg, bb = P.bb;
    unsigned zc[32];
#pragma unroll
    for (int o = 0; o < 32; ++o) zc[o] = *(const unsigned*)(T.ZC + (row0 + min(o, nout - 1)) * CC + c2);
    __builtin_amdgcn_sched_barrier(0);
#pragma unroll
    for (int o = 0; o < 32; ++o) {
        if (o < nout) {
            const float mean = stat[o * 2], rstd = stat[o * 2 + 1];
            const f32x2 y = (acc[o] - mean) * rstd * gg + bb;
            const unsigned z = zc[o];
            *(unsigned*)(T.CA + (row0 + o) * DM + c2) = cvtpk(siluf_(y.x) * bflo(z), siluf_(y.y) * bfhi(z));
        }
    }
    LDS_WAIT();
    __syncthreads();
}

template <int KSTEPS>
__device__ __forceinline__ f32x4 mini_dot(const bf16_t* arow, const bf16_t* brow) {
    f32x4 acc = (f32x4){0.f, 0.f, 0.f, 0.f};
    bf16x8 a[8], b[8];
#pragma unroll
    for (int u = 0; u < 8; ++u) { a[u] = *(const bf16x8*)(arow + 32 * u); b[u] = *(const bf16x8*)(brow + 32 * u); }
    for (int k0 = 0; k0 < KSTEPS; k0 += 8) {
#pragma unroll
        for (int u = 0; u < 8; ++u) {
            acc = __builtin_amdgcn_mfma_f32_16x16x32_bf16(b[u], a[u], acc, 0, 0, 0);
            if (k0 + 8 < KSTEPS) { a[u] = *(const bf16x8*)(arow + 32 * (k0 + 8 + u)); b[u] = *(const bf16x8*)(brow + 32 * (k0 + 8 + u)); }
        }
    }
    return acc;
}
__device__ __forceinline__ void side_p3(const bf16_t* CA, const bf16_t* WBT, const bf16_t* GC, const bf16_t* GA, bf16_t* MG, int vcu) {
    const int tid = threadIdx.x, lane = tid & 63, wid = tid >> 6, fr = lane & 15, fq = lane >> 4;
    const int rh = vcu & 1, c0 = (vcu >> 1) * 16;
    const size_t row = (size_t)ROW_S + rh * 128 + wid * 16 + fr;
    const bf16_t* ar = CA + row * DM + 8 * fq; const bf16_t* br = WBT + (size_t)(c0 + fr) * DM + 8 * fq;
    const f32x4 x0 = mini_dot<32>(ar, br), x1 = mini_dot<32>(ar + CC, br + CC);
    const size_t off = row * DM + c0 + 4 * fq;
    const u32x2 gc = *(const u32x2*)(GC + off), ga = *(const u32x2*)(GA + off);
    u32x2 o; o.x = cvtpk(bflo(gc.x) * x0[0] + bflo(ga.x) * x1[0], bfhi(gc.x) * x0[1] + bfhi(ga.x) * x1[1]); o.y = cvtpk(bflo(gc.y) * x0[2] + bflo(ga.y) * x1[2], bfhi(gc.y) * x0[3] + bfhi(ga.y) * x1[3]);
    *(u32x2*)(MG + off) = o;
}
__device__ __forceinline__ void side_p4(const bf16_t* MG, const bf16_t* WOT, const float* xs, float* ys, int vcu) {
    const int tid = threadIdx.x, lane = tid & 63, wid = tid >> 6, fr = lane & 15, fq = lane >> 4;
    const int rh = vcu & 1, c0 = (vcu >> 1) * 16;
    const int r = rh * 128 + wid * 16 + fr;
    const f32x4 acc = mini_dot<64>(MG + ((size_t)ROW_S + r) * DM + 8 * fq, WOT + (size_t)(c0 + fr) * DM + 8 * fq);
    const size_t off = (size_t)r * DM + c0 + 4 * fq;
    *(f32x4*)(ys + off) = *(const f32x4*)(xs + off) + acc;
}

__global__ void __launch_bounds__(NWAVES * 64, 2) fwd_kernel(Args args) {
    extern __shared__ __attribute__((aligned(16))) unsigned char lds_raw[];
    LAS unsigned char* lds = (LAS unsigned char*)lds_raw;
    volatile LAS unsigned* MISC = (volatile LAS unsigned*)(lds + MISC_OFF);
    const int tid = threadIdx.x, lane = tid & 63, wave = __builtin_amdgcn_readfirstlane(tid >> 6);
    const int G = gridDim.x; const int bx = blockIdx.x; const int vcu = (G % 8 == 0) ? (bx % 8) * (G / 8) + bx / 8 : bx;
    unsigned char* ws = args.ws;
    unsigned* ctl = (unsigned*)(ws + WS_CTL);
    for (int u = tid; u < (LDS_BYTES - LDSCTL_OFF) / 4; u += NWAVES * 64) ((LAS unsigned*)(lds + LDSCTL_OFF))[u] = 0u;
    __syncthreads();
    XcdBarrier bar = xcd_barrier_post(ctl + CW_BAR + args.li * XCD_BAR_WORDS, MISC + 8);
    const int lo = args.ph_lo, hi = args.ph_hi;
#ifndef PH_MASK
#define PH_MASK 31
#endif
#define IN(k) (((PH_MASK >> (k)) & 1) && lo <= (k) && (k) < hi)
#define BOTH(k) (IN(k) && IN((k) + 1))

    bf16_t* W1T = (bf16_t*)(ws + WS_W1T); bf16_t* WBT = (bf16_t*)(ws + WS_WBT); bf16_t* WOT = (bf16_t*)(ws + WS_WOT);
    bf16_t* Hb = (bf16_t*)(ws + WS_H); bf16_t* CA = (bf16_t*)(ws + WS_CA); bf16_t* MG = (bf16_t*)(ws + WS_MG);
    bf16_t* Qb = (bf16_t*)(ws + WS_QB); bf16_t* Kb = (bf16_t*)(ws + WS_KB); bf16_t* Vb = (bf16_t*)(ws + WS_VB);
    bf16_t* Kmb = (bf16_t*)(ws + WS_KMB); bf16_t* Vmb = (bf16_t*)(ws + WS_VMB); bf16_t* Ksb = (bf16_t*)(ws + WS_KSB); bf16_t* Vsb = (bf16_t*)(ws + WS_VSB); bf16_t* Qs = (bf16_t*)(ws + WS_QS);
    bf16_t* ZA = (bf16_t*)(ws + WS_ZA); bf16_t* GLU = (bf16_t*)(ws + WS_GLU); bf16_t* ZC = (bf16_t*)(ws + WS_ZC); bf16_t* GC = (bf16_t*)(ws + WS_GC); bf16_t* GA = (bf16_t*)(ws + WS_GA);
    bf16_t* Kcb = (bf16_t*)(ws + WS_KCB); bf16_t* Vcb = (bf16_t*)(ws + WS_VCB);
    unsigned char* H8 = ws + WS_H8; unsigned char* W8 = ws + WS_W8;

    if (IN(0)) {
        const int gw = vcu * NWAVES + wave, NGW = G * NWAVES;
        LAS float* scr = (LAS float*)(lds + wave * 16384);
        constexpr int I_1 = 64 * 176, I_B = 2 * 32 * 32, I_O = 64 * 32;
        for (int it = gw; it < I_1 + I_B + I_O; it += NGW) {
            int r = it;
            if (r < I_1) { const int kb = r / 176, nb = r % 176;
                if (nb >= 112) p0_transpose_item<true>(args.in[I_WIN], DIN, (bf16_t*)W8, DM, (2 * nb - 224) * 32, (2 * nb - 223) * 32, 0, scr, 32 * kb, 64 * nb, lane);
                else p0_transpose_item<false>(args.in[I_WIN], DIN, W1T, DM, w1_dst_row(2 * nb), w1_dst_row(2 * nb + 1), 0, scr, 32 * kb, 64 * nb, lane);
                continue; }
            r -= I_1;
            if (r < I_B) { const int br = r / 1024, rr = r % 1024, kb = rr / 32, nb = rr % 32; p0_transpose_item<false>(args.in[I_WB] + (size_t)br * CC * DM, DM, WBT, DM, 64 * nb, 64 * nb + 32, br * CC, scr, 32 * kb, 64 * nb, lane); continue; }
            r -= I_B;
            { const int kb = r / 32, nb = r % 32; p0_transpose_item<false>(args.in[I_WO], DM, WOT, DM, 64 * nb, 64 * nb + 32, 0, scr, 32 * kb, 64 * nb, lane); }
        }
        {
            f32x4 gv[8];
#pragma unroll
            for (int jj = 0; jj < 8; ++jj) gv[jj] = *((const f32x4*)args.in[I_NG] + lane + 64 * jj);
            for (int m = gw; m < MROWS; m += NGW) {
                u32x2* o8 = (u32x2*)(Hb + (size_t)m * DM) + lane;
                unsigned* o4 = (unsigned*)(H8 + (size_t)m * DM) + lane;
                if (m >= ROW_M + NMETA) {
#pragma unroll
                    for (int jj = 0; jj < 8; ++jj) { o8[64 * jj] = (u32x2){0u, 0u}; o4[64 * jj] = 0u; }
                    continue;
                }
                const float* xrow = m < ROW_S ? args.in[I_XP] + (size_t)m * DM : (m < ROW_M ? args.in[I_XS] + (size_t)(m - ROW_S) * DM : args.in[I_META] + (size_t)(m - ROW_M) * DM);
                const f32x4* xr = (const f32x4*)xrow + lane;
                f32x4 v[8]; float s = 0.f;
#pragma unroll
                for (int jj = 0; jj < 8; ++jj) { v[jj] = xr[64 * jj]; s += (v[jj][0] * v[jj][0] + v[jj][1] * v[jj][1]) + (v[jj][2] * v[jj][2] + v[jj][3] * v[jj][3]); }
                const float rs = __builtin_amdgcn_rsqf(wave_sum(s) * (1.f / DM) + EPS);
#pragma unroll
                for (int jj = 0; jj < 8; ++jj) { const f32x4 y = v[jj] * gv[jj] * rs; o8[64 * jj] = (u32x2){cvtpk(y[0], y[1]), cvtpk(y[2], y[3])};
                    int w8 = __builtin_amdgcn_cvt_pk_fp8_f32(y[0], y[1], 0, false); w8 = __builtin_amdgcn_cvt_pk_fp8_f32(y[2], y[3], w8, true); o4[64 * jj] = (unsigned)w8; }
            }
        }
        for (int it = gw; it < 2 * 128 * 16; it += NGW) {
            const int kv = it & 1, tile = it >> 1;
            const float* src = (kv ? args.in[I_CV] : args.in[I_CK]) + (size_t)tile * 64 * 128;
            bf16_t* dst = (kv ? Vcb : Kcb) + (size_t)tile * 8192;
#pragma unroll 4
            for (int i = 0; i < 16; ++i) {
                const int p = i * 64 + lane, key = p >> 4, dc = p & 15;
                const f32x4 a = *(const f32x4*)(src + key * 128 + dc * 8), c = *(const f32x4*)(src + key * 128 + dc * 8 + 4);
                const int off = kv ? ((dc >> 2) * 2048 + (key >> 4) * 512 + (key & 15) * 32 + (dc & 3) * 8) : (dc * 512 + key * 8);
                *(u32x4*)(dst + off) = pack8(a, c);
            }
        }
        {
            const int gt = vcu * (NWAVES * 64) + tid, NGT = G * NWAVES * 64; const u32x4 z = (u32x4){0u, 0u, 0u, 0u};
            for (int i = gt; i < 2 * 8 * 1024; i += NGT) ((u32x4*)Kmb)[i] = z;
            for (int i = gt; i < 2 * 128 * 1024; i += NGT) ((u32x4*)Ksb)[i] = z;
            for (int i = gt; i < 256; i += NGT) ((u32x4*)(Qs + (size_t)128 * SS * 128))[i] = z;
            for (int i = gt; i < NB * 30 * 128; i += NGT) { const int b = i / (30 * 128), r = i % (30 * 128); ((u32x4*)(GLU + (size_t)b * GLU_PB * CC))[r] = z; }
            for (int i = gt; i < 32 * 128; i += NGT) ((u32x4*)(GLU + (size_t)(GLU_S0 + SB * GLU_SB) * CC))[i] = z;
            for (int i = gt; i < SB * 30 * 128; i += NGT) { const int b = i / (30 * 128), r = i % (30 * 128); const float* sp = args.in[I_SC] + (size_t)b * 30 * CC + r * 8;
                ((u32x4*)(GLU + (size_t)(GLU_S0 + b * GLU_SB) * CC))[r] = pack8(*(const f32x4*)sp, *(const f32x4*)(sp + 4)); }
            for (int i = gt; i < SB * 14 * CC / 4; i += NGT) { const int b = i / (14 * CC / 4), r = i % (14 * CC / 4);
                ((f32x4*)(args.out + OFF_CS + (size_t)b * 30 * CC))[r] = ((const f32x4*)(args.in[I_SC] + ((size_t)b * 30 + 16) * CC))[r]; }
        }
        if (BOTH(0)) xcd_barrier(bar);
    }

    if (IN(1)) {
#ifndef NSTAT_A
#define NSTAT_A 11
#define NSTAT_B 5
#endif
        LAS unsigned* qmail = (LAS unsigned*)(lds + MISC_OFF + 64);
        const int qx = bx & 7, qslot = bx >> 3, qns = (G % 8 == 0) ? G / 8 : 0;
        { pg8::Gemm g{Hb, W1T, DM, DM, DM}; SchedIn S{{ctl + CW_GQ, qmail, qx, qslot, qns, 129 * 28 + 16, qns ? NSTAT_A : 0}};
          EpiIn E{args.out, args.in[I_QG], args.in[I_KG], Qb, Qs, Kb, Vb, Kmb, Vmb, Ksb, Vsb, ZA, GLU, ZC, GC, GA, 0};
          pg8::gemm_phase<EpiIn, SchedIn, true, false, true>(lds, g, S, E); }
        { pg8::Gemm g{(const bf16_t*)H8, (const bf16_t*)W8, DM / 2, DM / 2, DM / 2}; SchedGate S{{ctl + CW_GQ + 512, qmail, qx, qslot, qns, 129 * 16, qns ? NSTAT_B : 0}};
          EpiGate E{GC, GA};
          pg8::gemm_phase<EpiGate, SchedGate, true, true, true>(lds, g, S, E); }
        if (BOTH(1)) xcd_barrier(bar);
    }

    if (IN(2)) {
        float lam;
        { const float* lq = args.in[I_LQK]; const float a = wave_sum(lq[lane] * lq[64 + lane]), c = wave_sum(lq[128 + lane] * lq[192 + lane]); lam = __expf(a) - __expf(c) + 0.2f; }
        att::Tensors T{Qb, Qs, Kb, Vb, Kmb, Vmb, Ksb, Vsb, Kcb, Vcb, ZA, CA, args.in[I_RB], args.in[I_SLG]};
        for (int q = vcu; q < 2048; q += G) {
            const int i = q >> 8, v = q & 255, bh = v >> 1, p = v & 1, s = 4 * p + (i >> 1), j = (i & 1) ? 15 - s : s;
            att::attn_unit(T, 0, bh >> 3, bh & 7, j, lds, lam);
        }
        ConvT C{GLU, ZC, CA};
        LAS unsigned* qw = (LAS unsigned*)(lds + AUX_OFF + 3072);
        for (;;) {
            if (tid == 0) qw[0] = __hip_atomic_fetch_add(ctl + CW_Q, 1u, __ATOMIC_RELAXED, __HIP_MEMORY_SCOPE_AGENT);
            __syncthreads();
            const int item = (int)qw[0];
            __syncthreads();
            if (item >= 128) break;
            att::attn_unit(T, 1, item >> 3, item & 7, 0, lds, lam);
        }
        ConvW CP;
        { const int c2 = 2 * tid;
#pragma unroll
          for (int w = 0; w < CW; ++w) CP.W[w] = *(const f32x2*)(args.in[I_CWT] + w * CC + c2);
          CP.bias = *(const f32x2*)(args.in[I_CB] + c2); CP.gg = *(const f32x2*)(args.in[I_LNG] + c2); CP.bb = *(const f32x2*)(args.in[I_LNB] + c2); }
        for (;;) {
            if (tid == 0) qw[0] = __hip_atomic_fetch_add(ctl + CW_Q + 64, 1u, __ATOMIC_RELAXED, __HIP_MEMORY_SCOPE_AGENT);
            __syncthreads();
            const int item = (int)qw[0];
            __syncthreads();
            if (item >= 1024 + SB) break;
            conv_unit(C, CP, item, lds);
        }
        if (BOTH(2)) xcd_barrier(bar);
    }

    if (IN(3)) {
        for (int v = vcu; v < 256; v += G) side_p3(CA, WBT, GC, GA, MG, v);
        pg8::Gemm g{CA, WBT, DM, DM, CC}; SchedBr S{G, bx}; EpiBr E{GC, GA, MG};
        pg8::gemm_phase<EpiBr, SchedBr, true>(lds, g, S, E);
        if (BOTH(3)) xcd_barrier(bar);
    }

    if (IN(4)) {
        for (int v = vcu; v < 256; v += G) side_p4(MG, WOT, args.in[I_XS], args.out + OFF_YS, v);
        pg8::Gemm g{MG, WOT, DM, DM, DM}; SchedOut S{G, bx}; EpiOut E{args.in[I_XP], args.in[I_XS], args.out};
        pg8::gemm_phase<EpiOut, SchedOut, true>(lds, g, S, E);
    }
#undef IN
#undef BOTH
}

extern "C" void kernel_launch(void* const* d_in, const int* in_sizes, int n_in, void* d_out, int out_size, void* d_ws, size_t ws_size, hipStream_t stream) {
    static int grid = 0;
    if (grid == 0) {
        if (n_in != 19 || (size_t)out_size != OUT_TOTAL || ws_size < WS_END) { fprintf(stderr, "kernel_launch: unexpected shapes: n_in %d out %d ws %zu\n", n_in, out_size, ws_size); grid = -1; return; }
        int dev = 0, cus = 0, per_cu = 0;
        if (hipGetDevice(&dev) != hipSuccess || hipDeviceGetAttribute(&cus, hipDeviceAttributeMultiprocessorCount, dev) != hipSuccess) { grid = -1; return; }
        if (hipFuncSetAttribute((const void*)fwd_kernel, hipFuncAttributeMaxDynamicSharedMemorySize, LDS_BYTES) != hipSuccess) { fprintf(stderr, "kernel_launch: hipFuncSetAttribute failed\n"); grid = -1; return; }
        if (hipOccupancyMaxActiveBlocksPerMultiprocessor(&per_cu, (const void*)fwd_kernel, NWAVES * 64, LDS_BYTES) != hipSuccess || per_cu < 1)
            fprintf(stderr, "kernel_launch: note: occupancy query reports %d workgroups per CU\n", per_cu);
        (void)hipGetLastError();
        grid = cus;
    }
    if (grid < 0) return;
    (void)hipMemsetAsync((char*)d_ws + WS_CTL, 0, CTL_ZERO_BYTES, stream);
    Args a{};
    for (int i = 0; i < 19; ++i) a.in[i] = (const float*)d_in[i];
    a.out = (float*)d_out; a.ws = (unsigned char*)d_ws;
#ifndef PROBE_PROG
    a.ph_lo = 0; a.ph_hi = 5; a.li = 0;
    hipLaunchKernelGGL(fwd_kernel, dim3(grid), dim3(NWAVES * 64), LDS_BYTES, stream, a);
#else
    { static const int prog[] = {PROBE_PROG};
      for (int li = 0; li < (int)(sizeof(prog) / sizeof(prog[0])); ++li) { a.ph_lo = prog[li]; a.ph_hi = prog[li] + 1; a.li = li; hipLaunchKernelGGL(fwd_kernel, dim3(grid), dim3(NWAVES * 64), LDS_BYTES, stream, a); } }
#endif
}
```

```cpp
#include <hip/hip_runtime.h>
#include <cstdio>
#include <cstdint>

#define LAS __attribute__((address_space(3)))
#define GAS __attribute__((address_space(1)))
typedef unsigned short bf16_t;
typedef short bf16x8 __attribute__((ext_vector_type(8)));
typedef short s16x4 __attribute__((ext_vector_type(4)));
typedef float f32x2 __attribute__((ext_vector_type(2)));
typedef float f32x4 __attribute__((ext_vector_type(4)));
typedef float f32x16 __attribute__((ext_vector_type(16)));
typedef unsigned u32x2 __attribute__((ext_vector_type(2)));
typedef unsigned u32x4 __attribute__((ext_vector_type(4)));
typedef __bf16 bf16x2_t __attribute__((ext_vector_type(2)));

constexpr int DM = 2048, NB = 16, SEQ = 2048, NMETA = 16, LP = NMETA + SEQ, NH = 8, CC = 1024, CW = 31, DIN = 11264;
constexpr int SB = 16, SS = 16, PAST = 1024;
constexpr int ROW_S = NB * SEQ;
constexpr int ROW_M = ROW_S + SB * SS;
constexpr int MROWS = 33280;
constexpr float EPS = 1e-6f;
constexpr float LOG2E = 1.4426950408889634f;
constexpr float QSCALE = 0.125f * LOG2E;
constexpr size_t OFF_YP = 0, OFF_YS = OFF_YP + (size_t)NB * SEQ * DM, OFF_KP = OFF_YS + (size_t)SB * SS * DM, OFF_VP = OFF_KP + (size_t)NB * NH * LP * 128,
                 OFF_CP = OFF_VP + (size_t)NB * NH * LP * 128, OFF_KS = OFF_CP + (size_t)NB * 30 * CC, OFF_VS = OFF_KS + (size_t)SB * NH * SS * 128,
                 OFF_CS = OFF_VS + (size_t)SB * NH * SS * 128, OUT_TOTAL = OFF_CS + (size_t)SB * 30 * CC;
constexpr size_t MiB = 1u << 20;
constexpr size_t WS_CTL = 0, CTL_ZERO_BYTES = 1 * MiB;
constexpr size_t WS_W1T = 1 * MiB, WS_WBT = 45 * MiB, WS_WOT = 53 * MiB;
constexpr size_t WS_KMB = 61 * MiB, WS_VMB = WS_KMB + 128 * 1024, WS_KSB = 62 * MiB, WS_VSB = 64 * MiB, WS_QS = 66 * MiB;
constexpr size_t WS_H = 67 * MiB, WS_CA = 67 * MiB;
constexpr size_t WS_QB = 197 * MiB, WS_KB = 261 * MiB, WS_VB = 325 * MiB, WS_MG = 197 * MiB;
constexpr size_t WS_ZA = 389 * MiB, WS_GLU = 454 * MiB, WS_ZC = 522 * MiB, WS_GC = 587 * MiB, WS_GA = 716 * MiB;
constexpr size_t WS_KCB = 845 * MiB, WS_VCB = 877 * MiB, WS_H8 = 909 * MiB, WS_W8 = 974 * MiB, WS_END = 982 * MiB;
constexpr int GLU_PB = 30 + NMETA + SEQ, GLU_S0 = NB * GLU_PB, GLU_SB = 30 + SS, GLU_ROWS = GLU_S0 + SB * GLU_SB + 32;
constexpr int CW_BAR = 4096, CW_Q = 2048, CW_GQ = 32768;

constexpr int RING_BYTES = 131072, LDSCTL_OFF = RING_BYTES, MISC_OFF = LDSCTL_OFF + 320, AUX_OFF = RING_BYTES + 1024, LDS_BYTES = 147456;
constexpr int NWAVES = 8;

__device__ __forceinline__ unsigned cvtpk(float lo, float hi) { f32x2 v = {lo, hi}; bf16x2_t b = __builtin_convertvector(v, bf16x2_t); return __builtin_bit_cast(unsigned, b); }
__device__ __forceinline__ float bflo(unsigned w) { return __uint_as_float(w << 16); }
__device__ __forceinline__ float bfhi(unsigned w) { return __uint_as_float(w & 0xffff0000u); }
__device__ __forceinline__ float sigmoidf_(float x) { return __builtin_amdgcn_rcpf(1.f + __builtin_amdgcn_exp2f(-LOG2E * x)); }
__device__ __forceinline__ float siluf_(float x) { return x * sigmoidf_(x); }
__device__ __forceinline__ u32x4 pack8(const f32x4& a, const f32x4& b) { u32x4 w; w.x = cvtpk(a[0], a[1]); w.y = cvtpk(a[2], a[3]); w.z = cvtpk(b[0], b[1]); w.w = cvtpk(b[2], b[3]); return w; }
#define LDS_WAIT() asm volatile("s_waitcnt lgkmcnt(0)" ::: "memory")
#define VM_WAIT() asm volatile("s_waitcnt vmcnt(0)" ::: "memory")

namespace pg8 {
constexpr int BM = 256, BK = 64, HALF = 128, HTB = HALF * BK * 2, STAGE_BYTES = 8 * HTB, NXCD = 8, WGM = 4;
__host__ __device__ __forceinline__ int lds_byte(int r, int c) { const int st = (r >> 4) * 2 + (c >> 5), rr = r & 15, cc = c & 31, ob = rr * 64 + cc * 2; return st * 1024 + (ob ^ (((ob >> 9) & 1) << 5)); }
__host__ __device__ __forceinline__ void stage_rc(int b, int& R, int& C) { const int st = b / 1024, sb = b % 1024, swz = sb ^ (((sb >> 9) & 1) << 5); R = (st >> 1) * 16 + swz / 64; C = (st & 1) * 32 + (swz % 64) / 2; }
__host__ __device__ __forceinline__ int perm32(int rho) { const int n = rho >> 4, i = rho & 15; return 8 * (i >> 2) + 4 * n + (i & 3); }

struct Unit { int pm, pn, ko, aux; };
struct Gemm { const bf16_t* A; const bf16_t* Bt; int lda, ldb, K; };

__device__ __forceinline__ void tile_of(int L, int nM, int nN, int& pm, int& pn) {
    const int nwg = nM * nN; int wgid = L;
    { const int q = nwg / NXCD, r = nwg % NXCD, xcd = wgid % NXCD, off = wgid / NXCD; wgid = (xcd < r ? xcd * (q + 1) : r * (q + 1) + (xcd - r) * q) + off; }
    const int nig = WGM * nN, gid = wgid / nig, fm = gid * WGM, gsz = (nM - fm) < WGM ? (nM - fm) : WGM;
    pm = fm + ((wgid % nig) % gsz); pn = (wgid % nig) / gsz;
}

struct DynQ { unsigned* ctr; LAS unsigned* mail; int x, slot, nslot, nwg, nstat; };
__device__ __forceinline__ unsigned dq_issue(const DynQ& q, int cursor) {
    unsigned k = 0u;
    if (threadIdx.x == 0) k = __hip_atomic_fetch_add(q.ctr + 64 * cursor, 1u, __ATOMIC_RELAXED, __HIP_MEMORY_SCOPE_AGENT);
    return k;
}
__device__ __forceinline__ int dq_finish(const DynQ& q, int& cursor, unsigned k0) {
    if (threadIdx.x == 0) {
        int L = -1, y = cursor; unsigned k = k0;
        for (int tries = 0; ; ) {
            const long Lc = ((long)k + (long)q.nstat * q.nslot) * 8 + y;
            if (Lc < q.nwg) { L = (int)Lc; break; }
            if (++tries == 8) break;
            y = (y + 1) & 7; k = __hip_atomic_fetch_add(q.ctr + 64 * y, 1u, __ATOMIC_RELAXED, __HIP_MEMORY_SCOPE_AGENT);
        }
        q.mail[0] = (unsigned)L; q.mail[1] = (unsigned)y;
    }
    asm volatile("s_waitcnt lgkmcnt(0)" ::: "memory"); __builtin_amdgcn_s_barrier(); asm volatile("" ::: "memory");
    const int L = __builtin_amdgcn_readfirstlane((int)q.mail[0]); cursor = __builtin_amdgcn_readfirstlane((int)q.mail[1]);
    return L;
}

typedef int v4i32 __attribute__((ext_vector_type(4)));
typedef int v8i32 __attribute__((ext_vector_type(8)));
template <class Epi, class Sched, bool ALIGN_EPI, bool FP8 = false, bool DYN = false>
__device__ __forceinline__ void gemm_phase(LAS unsigned char* lds, const Gemm g, const Sched& S, const Epi& E) {
    const int tid = threadIdx.x, wid = __builtin_amdgcn_readfirstlane(tid >> 6), lane = tid & 63, wr = wid >> 2, wc = wid & 3, fr = lane & 15, fq = lane >> 4;
    const int nt = g.K / BK;
    unsigned voffA[2], voffB[2];
#pragma unroll
    for (int i = 0; i < 2; ++i) { int R, C; stage_rc(tid * 16 + i * 8192, R, C); const int Rb = (R & ~31) + perm32(R & 31);
        voffA[i] = (unsigned)(R * g.lda + C) * 2u; voffB[i] = (unsigned)(Rb * g.ldb + C) * 2u; }
    const size_t kstep = (size_t)(BK * 2);
    const size_t hstepA = (size_t)HALF * g.lda * 2, hstepB = (size_t)HALF * g.ldb * 2;
    const unsigned ldsw = (unsigned)wid * 1024u, lds0 = (unsigned)(uintptr_t)lds;
    const int fcol = fq * 8;
    const int aoff = lds_byte(wr * 64 + fr, fcol), boff = lds_byte(wc * 32 + fr, fcol);
    constexpr int KOFF = 1024;
    int sc_w = 121, sc_a = 127; asm volatile("" : "+v"(sc_w), "+v"(sc_a));
#define PG8_SA(b, h) (((b) * 2 + (h)) * HTB)
#define PG8_SB(b, h) ((4 + (b) * 2 + (h)) * HTB)
#define PG8_STAGE(bufoff, gbase, voff) do { _Pragma("unroll") for (int _i = 0; _i < 2; ++_i) { unsigned keep_; \
        asm volatile("s_mov_b32 %0, m0\n\ts_mov_b32 m0, %3\n\ts_nop 0\n\tglobal_load_lds_dwordx4 %1, %2\n\ts_mov_b32 m0, %0" \
                     : "=&s"(keep_) : "v"((voff)[_i]), "s"((const char*)(gbase)), "s"((unsigned)__builtin_amdgcn_readfirstlane((int)(lds0 + (bufoff) + ldsw + _i * 8192))) : "memory"); } } while (0)
#define PG8_LDA(dst, b, h) do { _Pragma("unroll") for (int m = 0; m < 4; ++m) _Pragma("unroll") for (int k = 0; k < 2; ++k) dst[m][k] = *(const LAS bf16x8*)(lds + PG8_SA(b, h) + aoff + m * 2048 + k * KOFF); } while (0)
#define PG8_LDB(dst, b, h) do { _Pragma("unroll") for (int n = 0; n < 2; ++n) _Pragma("unroll") for (int k = 0; k < 2; ++k) dst[n][k] = *(const LAS bf16x8*)(lds + PG8_SB(b, h) + boff + n * 2048 + k * KOFF); } while (0)
#define PG8_MMA(ai, bj, At, Bt) do { __builtin_amdgcn_s_setprio(1); \
        if constexpr (FP8) { _Pragma("unroll") for (int n = 0; n < 2; ++n) _Pragma("unroll") for (int m = 0; m < 4; ++m) { \
            const v8i32 bw_ = __builtin_shufflevector(__builtin_bit_cast(v4i32, Bt[n][0]), __builtin_bit_cast(v4i32, Bt[n][1]), 0, 1, 2, 3, 4, 5, 6, 7); \
            const v8i32 aw_ = __builtin_shufflevector(__builtin_bit_cast(v4i32, At[m][0]), __builtin_bit_cast(v4i32, At[m][1]), 0, 1, 2, 3, 4, 5, 6, 7); \
            asm volatile("v_mfma_scale_f32_16x16x128_f8f6f4 %0, %1, %2, %0, %3, %4 op_sel_hi:[0,0,0]" : "+v"(acc[ai][bj][m][n]) : "v"(bw_), "v"(aw_), "v"(sc_w), "v"(sc_a)); } \
        } else { _Pragma("unroll") for (int m = 0; m < 4; ++m) _Pragma("unroll") for (int n = 0; n < 2; ++n) _Pragma("unroll") for (int k = 0; k < 2; ++k) { \
            acc[ai][bj][m][n] = __builtin_amdgcn_mfma_f32_16x16x32_bf16(Bt[n][k], At[m][k], acc[ai][bj][m][n], 0, 0, 0); \
            __builtin_amdgcn_sched_barrier(0); } } \
        __builtin_amdgcn_s_setprio(0); } while (0)
#define PG8_WAIT_V(n) asm volatile("s_waitcnt vmcnt(" #n ")" ::: "memory")
#define PG8_WAIT_L(n) asm volatile("s_waitcnt lgkmcnt(" #n ")" ::: "memory")
#define PG8_BAR __builtin_amdgcn_s_barrier()
#define PG8_SCHED __builtin_amdgcn_sched_barrier(0)
    Unit cur, nxt, nn; int ui = 0; bool nxt_ok = false, nn_ok = false; int dq_cur = 0; unsigned dq_k0 = 0u;
    if constexpr (DYN) {
        static_assert(ALIGN_EPI, "the dequeue broadcast needs the two half-workgroups aligned at the epilogue");
        dq_cur = S.q.x;
        if (S.q.nslot > 0) {
            if (!S.map(S.q.slot * 8 + S.q.x, cur)) return;
            nxt_ok = S.map((S.q.nslot + S.q.slot) * 8 + S.q.x, nxt);
        } else {
            const int L0 = dq_finish(S.q, dq_cur, dq_issue(S.q, dq_cur)); if (L0 < 0 || !S.map(L0, cur)) return;
            const int L1 = dq_finish(S.q, dq_cur, dq_issue(S.q, dq_cur)); nxt_ok = L1 >= 0 && S.map(L1, nxt);
        }
    } else { if (!S.next(0, cur)) return; }
    f32x4 acc[2][2][4][2];
    typename Epi::Carry carry;
#pragma unroll
    for (int a = 0; a < 2; ++a)
#pragma unroll
        for (int b = 0; b < 2; ++b)
#pragma unroll
            for (int m = 0; m < 4; ++m)
#pragma unroll
                for (int n = 0; n < 2; ++n) acc[a][b][m][n] = (f32x4){0.f, 0.f, 0.f, 0.f};
    bf16x8 At[4][2], B0[2][2], B1[2][2];
    const char* cA = (const char*)g.A + (size_t)cur.pm * 2 * hstepA + (size_t)cur.ko * 2; const char* cB = (const char*)g.Bt + (size_t)cur.pn * 2 * hstepB + (size_t)cur.ko * 2;
    PG8_STAGE(PG8_SB(0, 0), cB, voffB); PG8_STAGE(PG8_SB(0, 1), cB + hstepB, voffB); PG8_STAGE(PG8_SA(0, 0), cA, voffA); PG8_STAGE(PG8_SA(0, 1), cA + hstepA, voffA);
    if (wr == 1) PG8_BAR;
    PG8_WAIT_V(2); PG8_BAR;
    PG8_STAGE(PG8_SB(1, 0), cB + kstep, voffB); PG8_STAGE(PG8_SA(1, 0), cA + kstep, voffA); PG8_STAGE(PG8_SB(1, 1), cB + hstepB + kstep, voffB);
    PG8_WAIT_V(6); PG8_BAR;
    for (;;) {
        bool has_next;
        if constexpr (DYN) has_next = nxt_ok; else has_next = S.next(ui + 1, nxt);
        const char* nA = has_next ? (const char*)g.A + (size_t)nxt.pm * 2 * hstepA + (size_t)nxt.ko * 2 : cA;
        const char* nB = has_next ? (const char*)g.Bt + (size_t)nxt.pn * 2 * hstepB + (size_t)nxt.ko * 2 : cB;
        for (int t = 0; t < nt; t += 2) {
            const bool last = (t == nt - 2);
            const char* a1 = cA + (size_t)(t + 1) * kstep;
            const char* a2 = last ? nA : cA + (size_t)(t + 2) * kstep; const char* b2 = last ? nB : cB + (size_t)(t + 2) * kstep;
            const char* a3 = a2 + kstep; const char* b3 = b2 + kstep;
            if constexpr (Epi::MID_T > 0) { if (t == Epi::MID_T) E.mid(acc, cur, wr, wc, fr, fq, carry); }
            PG8_LDB(B0, 0, 0); PG8_LDB(B1, 0, 1); PG8_SCHED; PG8_LDA(At, 0, 0); PG8_STAGE(PG8_SA(1, 1), a1 + hstepA, voffA);
            PG8_WAIT_V(8); PG8_WAIT_L(0); PG8_BAR; PG8_MMA(0, 0, At, B0); PG8_MMA(0, 1, At, B1); PG8_BAR; PG8_SCHED;
            PG8_LDA(At, 0, 1); PG8_STAGE(PG8_SB(0, 0), b2, voffB); PG8_STAGE(PG8_SB(0, 1), b2 + hstepB, voffB); PG8_STAGE(PG8_SA(0, 0), a2, voffA);
            PG8_WAIT_V(8); PG8_WAIT_L(0); PG8_BAR; PG8_MMA(1, 0, At, B0); PG8_MMA(1, 1, At, B1); PG8_BAR; PG8_SCHED;
            PG8_LDB(B0, 1, 0); PG8_LDB(B1, 1, 1); PG8_SCHED; PG8_LDA(At, 1, 0); PG8_STAGE(PG8_SA(0, 1), a2 + hstepA, voffA);
            PG8_WAIT_V(8); PG8_WAIT_L(0); PG8_BAR; PG8_MMA(0, 0, At, B0); PG8_MMA(0, 1, At, B1); PG8_BAR; PG8_SCHED;
            PG8_LDA(At, 1, 1); PG8_STAGE(PG8_SB(1, 0), b3, voffB); PG8_STAGE(PG8_SB(1, 1), b3 + hstepB, voffB); PG8_STAGE(PG8_SA(1, 0), a3, voffA);
            PG8_WAIT_V(8); PG8_WAIT_L(0); PG8_BAR; PG8_MMA(1, 0, At, B0); PG8_MMA(1, 1, At, B1); PG8_BAR; PG8_SCHED;
        }
        if constexpr (ALIGN_EPI) { if (wr == 0) PG8_BAR; }
        if constexpr (FP8) asm volatile("s_nop 15\n\ts_nop 7" ::: "memory");
        if constexpr (DYN) { if (has_next && ui + 2 >= S.q.nstat) dq_k0 = dq_issue(S.q, dq_cur); }
        if constexpr (Epi::MID_T > 0) E(acc, cur, wr, wc, fr, fq, carry); else E(acc, cur, wr, wc, fr, fq);
        if (!has_next) break;
        if constexpr (DYN) {
            if (ui + 2 < S.q.nstat) nn_ok = S.map(((ui + 2) * S.q.nslot + S.q.slot) * 8 + S.q.x, nn);
            else { const int L2 = dq_finish(S.q, dq_cur, dq_k0); nn_ok = L2 >= 0 && S.map(L2, nn); } }
#pragma unroll
        for (int a = 0; a < 2; ++a)
#pragma unroll
            for (int b = 0; b < 2; ++b)
#pragma unroll
                for (int m = 0; m < 4; ++m)
#pragma unroll
                    for (int n = 0; n < 2; ++n) acc[a][b][m][n] = (f32x4){0.f, 0.f, 0.f, 0.f};
        cur = nxt; cA = nA; cB = nB; ++ui;
        if constexpr (DYN) { nxt = nn; nxt_ok = nn_ok; }
        if constexpr (ALIGN_EPI) { if (wr == 1) PG8_BAR; }
    }
    PG8_WAIT_V(0);
    if constexpr (!ALIGN_EPI) { if (wr == 0) PG8_BAR; }
    PG8_BAR;
#undef PG8_SA
#undef PG8_SB
#undef PG8_STAGE
#undef PG8_LDA
#undef PG8_LDB
#undef PG8_MMA
#undef PG8_WAIT_V
#undef PG8_WAIT_L
#undef PG8_BAR
#undef PG8_SCHED
}
}

__device__ __forceinline__ unsigned pack_u8x4(const f32x4& v) { unsigned w = 0u;
    w = __builtin_amdgcn_cvt_pk_u8_f32(v[0] * 255.f, 0, w); w = __builtin_amdgcn_cvt_pk_u8_f32(v[1] * 255.f, 1, w); w = __builtin_amdgcn_cvt_pk_u8_f32(v[2] * 255.f, 2, w); w = __builtin_amdgcn_cvt_pk_u8_f32(v[3] * 255.f, 3, w); return w; }
__device__ __forceinline__ f32x4 unpack_u8x4(unsigned w) {
    return (f32x4){(float)(w & 0xffu), (float)((w >> 8) & 0xffu), (float)((w >> 16) & 0xffu), (float)(w >> 24)}; }
struct Args {
    const float* in[19];
    float* out; unsigned char* ws;
    int ph_lo, ph_hi, li, pad;
};
enum { I_XP = 0, I_XS, I_CK, I_CV, I_SC, I_META, I_RB, I_NG, I_WIN, I_QG, I_KG, I_LQK, I_SLG, I_CWT, I_CB, I_LNG, I_LNB, I_WB, I_WO };

struct SchedIn {
    pg8::DynQ q;
    __device__ __forceinline__ bool map(int L, pg8::Unit& u) const {
        constexpr int NREG = 129 * 28;
        u.ko = 0; u.aux = 0;
        if (L < NREG) { pg8::tile_of(L, 129, 28, u.pm, u.pn); return true; }
        const int e = L - NREG; if (e >= 16) return false;
        u.pm = 129; u.pn = e < 8 ? 4 + e : 8 + e; return true;
    }
    __device__ __forceinline__ bool next(int, pg8::Unit&) const { return false; }
};
struct SchedGate {
    pg8::DynQ q;
    __device__ __forceinline__ bool map(int L, pg8::Unit& u) const {
        if (L >= 129 * 16) return false;
        pg8::tile_of(L, 129, 16, u.pm, u.pn); u.ko = 0; u.aux = 0; return true;
    }
    __device__ __forceinline__ bool next(int, pg8::Unit&) const { return false; }
};

struct EpiIn {
    static constexpr int MID_T = 0; struct Carry {};
    float* out; const float* qg; const float* kg;
    bf16_t *Qb, *Qs, *Kb, *Vb, *Kmb, *Vmb, *Ksb, *Vsb, *ZA, *GLU, *ZC, *GC, *GA; int pn_base;
    __device__ __forceinline__ void operator()(const f32x4 (&acc)[2][2][4][2], const pg8::Unit& u, int wr, int wc, int fr, int fq) const {
        asm volatile("" : "+v"(fr), "+v"(fq));
        const int pm = u.pm, pn = u.pn + pn_base;
        const int kind = pm < 128 ? 0 : (pm == 128 ? 1 : 2);
        if (pn < 8) {
            const bool isk = pn >= 4; const int head = 2 * (pn & 3) + (wc >> 1), map = wc & 1;
            const float* gp = (isk ? kg : qg) + head * 64 + 8 * fq;
            f32x4 gv[2][2];
#pragma unroll
            for (int bj = 0; bj < 2; ++bj)
#pragma unroll
                for (int n = 0; n < 2; ++n) gv[bj][n] = *(const f32x4*)(gp + 32 * bj + 4 * n);
            const float osc = isk ? 1.f : QSCALE;
#pragma unroll
            for (int ai = 0; ai < 2; ++ai)
#pragma unroll
                for (int m = 0; m < 4; ++m) {
                    float ss = 0.f;
#pragma unroll
                    for (int bj = 0; bj < 2; ++bj)
#pragma unroll
                        for (int n = 0; n < 2; ++n) { const f32x4 v = acc[ai][bj][m][n]; ss += (v[0] * v[0] + v[1] * v[1]) + (v[2] * v[2] + v[3] * v[3]); }
                    ss += __shfl_xor(ss, 16); ss += __shfl_xor(ss, 32);
                    const float rs = __builtin_amdgcn_rsqf(ss * (1.f / 64.f) + EPS) * osc;
                    f32x4 o[2][2];
#pragma unroll
                    for (int bj = 0; bj < 2; ++bj)
#pragma unroll
                        for (int n = 0; n < 2; ++n) o[bj][n] = acc[ai][bj][m][n] * gv[bj][n] * rs;
                    const int rl = ai * 128 + wr * 64 + m * 16 + fr;
                    if (kind == 0) {
                        const int b = pm >> 3, t = (pm & 7) * 256 + rl, bh = b * NH + head;
                        if (!isk) {
                            bf16_t* q = Qb + ((size_t)bh * SEQ + t) * 128 + map * 64 + 8 * fq;
#pragma unroll
                            for (int bj = 0; bj < 2; ++bj) *(u32x4*)(q + 32 * bj) = pack8(o[bj][0], o[bj][1]);
                        } else {
                            float* kf = out + OFF_KP + ((size_t)bh * LP + NMETA + t) * 128 + map * 64 + 8 * fq;
                            bf16_t* kb = Kb + ((size_t)bh * 32 + (t >> 6)) * 8192 + (map * 8 + fq) * 512 + (t & 63) * 8;
#pragma unroll
                            for (int bj = 0; bj < 2; ++bj) { *(f32x4*)(kf + 32 * bj) = o[bj][0]; *(f32x4*)(kf + 32 * bj + 4) = o[bj][1]; *(u32x4*)(kb + bj * 4 * 512) = pack8(o[bj][0], o[bj][1]); }
                        }
                    } else if (kind == 1) {
                        const int b = rl >> 4, s = rl & 15, bh = b * NH + head;
                        if (!isk) {
                            bf16_t* q = Qs + ((size_t)bh * SS + s) * 128 + map * 64 + 8 * fq;
#pragma unroll
                            for (int bj = 0; bj < 2; ++bj) *(u32x4*)(q + 32 * bj) = pack8(o[bj][0], o[bj][1]);
                        } else {
                            float* kf = out + OFF_KS + ((size_t)bh * SS + s) * 128 + map * 64 + 8 * fq;
                            bf16_t* kb = Ksb + (size_t)bh * 8192 + (map * 8 + fq) * 512 + s * 8;
#pragma unroll
                            for (int bj = 0; bj < 2; ++bj) { *(f32x4*)(kf + 32 * bj) = o[bj][0]; *(f32x4*)(kf + 32 * bj + 4) = o[bj][1]; *(u32x4*)(kb + bj * 4 * 512) = pack8(o[bj][0], o[bj][1]); }
                        }
                    } else if (isk && rl < NMETA) {
                        bf16_t* kb = Kmb + (size_t)head * 8192 + (map * 8 + fq) * 512 + rl * 8;
#pragma unroll
                        for (int bj = 0; bj < 2; ++bj) *(u32x4*)(kb + bj * 4 * 512) = pack8(o[bj][0], o[bj][1]);
                        for (int b = 0; b < NB; ++b) {
                            float* kf = out + OFF_KP + ((size_t)(b * NH + head) * LP + rl) * 128 + map * 64 + 8 * fq;
#pragma unroll
                            for (int bj = 0; bj < 2; ++bj) { *(f32x4*)(kf + 32 * bj) = o[bj][0]; *(f32x4*)(kf + 32 * bj + 4) = o[bj][1]; }
                        }
                    }
                }
        } else if (pn < 12) {
#pragma unroll
            for (int ai = 0; ai < 2; ++ai)
#pragma unroll
                for (int m = 0; m < 4; ++m) {
                    const int rl = ai * 128 + wr * 64 + m * 16 + fr;
#pragma unroll
                    for (int bj = 0; bj < 2; ++bj) {
                        const int head = 2 * (pn - 8) + bj; const f32x4 v0 = acc[ai][bj][m][0], v1 = acc[ai][bj][m][1]; const u32x4 w = pack8(v0, v1);
                        if (kind == 0) {
                            const int b = pm >> 3, t = (pm & 7) * 256 + rl, bh = b * NH + head;
                            float* vf = out + OFF_VP + ((size_t)bh * LP + NMETA + t) * 128 + 32 * wc + 8 * fq;
                            *(f32x4*)vf = v0; *(f32x4*)(vf + 4) = v1;
                            *(u32x4*)(Vb + ((size_t)bh * 32 + (t >> 6)) * 8192 + wc * 2048 + ((t >> 4) & 3) * 512 + (t & 15) * 32 + fq * 8) = w;
                        } else if (kind == 1) {
                            const int b = rl >> 4, s = rl & 15, bh = b * NH + head;
                            float* vf = out + OFF_VS + ((size_t)bh * SS + s) * 128 + 32 * wc + 8 * fq;
                            *(f32x4*)vf = v0; *(f32x4*)(vf + 4) = v1;
                            *(u32x4*)(Vsb + (size_t)bh * 8192 + wc * 2048 + s * 32 + fq * 8) = w;
                        } else if (rl < NMETA) {
                            *(u32x4*)(Vmb + (size_t)head * 8192 + wc * 2048 + rl * 32 + fq * 8) = w;
                            for (int b = 0; b < NB; ++b) { float* vf = out + OFF_VP + ((size_t)(b * NH + head) * LP + rl) * 128 + 32 * wc + 8 * fq; *(f32x4*)vf = v0; *(f32x4*)(vf + 4) = v1; }
                        }
                    }
                }
        } else if (pn >= 16 && pn < 24) {
            const int j0 = 128 * (pn - 16) + 32 * wc + 8 * fq;
#pragma unroll
            for (int ai = 0; ai < 2; ++ai)
#pragma unroll
                for (int m = 0; m < 4; ++m) {
                    const int rl = ai * 128 + wr * 64 + m * 16 + fr;
                    f32x4 o[2];
#pragma unroll
                    for (int n = 0; n < 2; ++n) { const f32x4 a = acc[ai][0][m][n], gg = acc[ai][1][m][n];
                        o[n] = (f32x4){a[0] * sigmoidf_(gg[0]), a[1] * sigmoidf_(gg[1]), a[2] * sigmoidf_(gg[2]), a[3] * sigmoidf_(gg[3])}; }
                    const u32x4 gw = pack8(o[0], o[1]);
                    if (kind == 0) {
                        const int b = pm >> 3, t = (pm & 7) * 256 + rl;
                        *(u32x4*)(GLU + ((size_t)b * GLU_PB + 30 + NMETA + t) * CC + j0) = gw;
                        if (t >= SEQ - 30) { float* cf = out + OFF_CP + ((size_t)b * 30 + (t - (SEQ - 30))) * CC + j0; *(f32x4*)cf = o[0]; *(f32x4*)(cf + 4) = o[1]; }
                    } else if (kind == 1) {
                        const int b = rl >> 4, s = rl & 15;
                        *(u32x4*)(GLU + ((size_t)GLU_S0 + b * GLU_SB + 30 + s) * CC + j0) = gw;
                        float* cf = out + OFF_CS + ((size_t)b * 30 + 14 + s) * CC + j0; *(f32x4*)cf = o[0]; *(f32x4*)(cf + 4) = o[1];
                    } else if (rl < NMETA) {
                        for (int b = 0; b < NB; ++b) *(u32x4*)(GLU + ((size_t)b * GLU_PB + 30 + rl) * CC + j0) = gw;
                    }
                }
        } else {
            if (pn < 16) act_store<true>(acc, ZA, CC, 256 * (pn - 12) + 32 * wc + 8 * fq, pm * 256 + wr * 64 + fr);
            else if (pn < 28) act_store<true>(acc, ZC, CC, 256 * (pn - 24) + 32 * wc + 8 * fq, pm * 256 + wr * 64 + fr);
            else if (pn < 36) act_store<false>(acc, GC, DM, 256 * (pn - 28) + 32 * wc + 8 * fq, pm * 256 + wr * 64 + fr);
            else act_store<false>(acc, GA, DM, 256 * (pn - 36) + 32 * wc + 8 * fq, pm * 256 + wr * 64 + fr);
        }
    }
    template <bool SIL> static __device__ __forceinline__ void act_store(const f32x4 (&acc)[2][2][4][2], bf16_t* base, int ld, int c0, int row0) {
#pragma unroll
        for (int ai = 0; ai < 2; ++ai)
#pragma unroll
            for (int m = 0; m < 4; ++m) {
                const int row = row0 + ai * 128 + m * 16;
#pragma unroll
                for (int bj = 0; bj < 2; ++bj) {
                    f32x4 o[2];
#pragma unroll
                    for (int n = 0; n < 2; ++n) { const f32x4 v = acc[ai][bj][m][n]; const f32x4 sg = (f32x4){sigmoidf_(v[0]), sigmoidf_(v[1]), sigmoidf_(v[2]), sigmoidf_(v[3])}; o[n] = SIL ? v * sg : sg; }
                    *(u32x4*)(base + (size_t)row * ld + c0 + 128 * bj) = pack8(o[0], o[1]);
                }
            }
    }
};

struct EpiGate {
    static constexpr int MID_T = 0; struct Carry {};
    bf16_t *GC, *GA;
    __device__ __forceinline__ void operator()(const f32x4 (&acc)[2][2][4][2], const pg8::Unit& u, int wr, int wc, int fr, int fq) const {
        asm volatile("" : "+v"(fr), "+v"(fq));
        unsigned char* base = (unsigned char*)(u.pn < 8 ? GC : GA) + (size_t)(u.pm * 256 + wr * 64 + fr) * DM + 256 * (u.pn & 7) + 32 * wc + 8 * fq;
#pragma unroll
        for (int ai = 0; ai < 2; ++ai)
#pragma unroll
            for (int m = 0; m < 4; ++m)
#pragma unroll
                for (int bj = 0; bj < 2; ++bj) {
                    f32x4 o[2];
#pragma unroll
                    for (int n = 0; n < 2; ++n) { const f32x4 v = acc[ai][bj][m][n]; o[n] = (f32x4){sigmoidf_(v[0]), sigmoidf_(v[1]), sigmoidf_(v[2]), sigmoidf_(v[3])}; }
                    *(u32x2*)(base + (size_t)(ai * 128 + m * 16) * DM + 128 * bj) = (u32x2){pack_u8x4(o[0]), pack_u8x4(o[1])};
                }
    }
};

struct SchedBr {
    int G, c;
    __device__ __forceinline__ bool next(int i, pg8::Unit& u) const {
        const int L = i * G + c; if (L >= 128 * 8) return false;
        pg8::tile_of(L, 128, 8, u.pm, u.pn); u.aux = 0; u.ko = 0; return true;
    }
};
struct EpiBr {
    static constexpr int MID_T = 16;
    static constexpr float GFLOOR = 1e-18f;
    struct Carry { u32x2 h[2][4][2]; };
    const bf16_t* GC; const bf16_t* GA; bf16_t* MG;
    __device__ __forceinline__ void mid(f32x4 (&acc)[2][2][4][2], const pg8::Unit& u, int wr, int wc, int fr, int fq, Carry& c) const {
        asm volatile("" : "+v"(fr), "+v"(fq));
        const size_t base = ((size_t)u.pm * 256 + wr * 64 + fr) * DM + u.pn * 256 + wc * 32 + 8 * fq;
        u32x2 gw[2][4][2];
#pragma unroll
        for (int ai = 0; ai < 2; ++ai)
#pragma unroll
            for (int m = 0; m < 4; ++m)
#pragma unroll
                for (int bj = 0; bj < 2; ++bj) { const size_t off = base + (size_t)(ai * 128 + m * 16) * DM + bj * 128; gw[ai][m][bj] = *(const u32x2*)((const unsigned char*)GC + off); c.h[ai][m][bj] = *(const u32x2*)((const unsigned char*)GA + off); }
        __builtin_amdgcn_sched_barrier(0);
#pragma unroll
        for (int ai = 0; ai < 2; ++ai)
#pragma unroll
            for (int m = 0; m < 4; ++m)
#pragma unroll
                for (int bj = 0; bj < 2; ++bj) {
                    const u32x2 g = gw[ai][m][bj], h = c.h[ai][m][bj];
                    const f32x4 g0 = unpack_u8x4(g.x), g1 = unpack_u8x4(g.y), h0 = unpack_u8x4(h.x), h1 = unpack_u8x4(h.y);
#define BR_R(gv, hv) ((gv) * __builtin_amdgcn_rcpf(fmaxf((hv), 255.f * GFLOOR)))
                    acc[ai][bj][m][0] *= (f32x4){BR_R(g0[0], h0[0]), BR_R(g0[1], h0[1]), BR_R(g0[2], h0[2]), BR_R(g0[3], h0[3])};
                    acc[ai][bj][m][1] *= (f32x4){BR_R(g1[0], h1[0]), BR_R(g1[1], h1[1]), BR_R(g1[2], h1[2]), BR_R(g1[3], h1[3])};
#undef BR_R
                }
        __builtin_amdgcn_sched_barrier(0);
    }
    __device__ __forceinline__ void operator()(const f32x4 (&acc)[2][2][4][2], const pg8::Unit& u, int wr, int wc, int fr, int fq, const Carry& c) const {
        asm volatile("" : "+v"(fr), "+v"(fq));
        const size_t base = ((size_t)u.pm * 256 + wr * 64 + fr) * DM + u.pn * 256 + wc * 32 + 8 * fq;
#pragma unroll
        for (int ai = 0; ai < 2; ++ai)
#pragma unroll
            for (int m = 0; m < 4; ++m)
#pragma unroll
                for (int bj = 0; bj < 2; ++bj) {
                    const size_t off = base + (size_t)(ai * 128 + m * 16) * DM + bj * 128;
                    const u32x2 h = c.h[ai][m][bj]; const f32x4 a0 = acc[ai][bj][m][0], a1 = acc[ai][bj][m][1];
                    const f32x4 h0 = unpack_u8x4(h.x), h1 = unpack_u8x4(h.y);
#define BR_F(hv) (fmaxf((hv), 255.f * GFLOOR) * (1.f / 255.f))
                    const f32x4 o0 = (f32x4){BR_F(h0[0]) * a0[0], BR_F(h0[1]) * a0[1], BR_F(h0[2]) * a0[2], BR_F(h0[3]) * a0[3]};
                    const f32x4 o1 = (f32x4){BR_F(h1[0]) * a1[0], BR_F(h1[1]) * a1[1], BR_F(h1[2]) * a1[2], BR_F(h1[3]) * a1[3]};
#undef BR_F
                    *(u32x4*)(MG + off) = pack8(o0, o1);
                }
    }
};
struct SchedOut {
    int G, c;
    __device__ __forceinline__ bool next(int i, pg8::Unit& u) const {
        const int L = i * G + c; if (L >= 128 * 8) return false;
        pg8::tile_of(L, 128, 8, u.pm, u.pn); u.aux = 0; u.ko = 0; return true;
    }
};
struct EpiOut {
    static constexpr int MID_T = 0; struct Carry {};
    const float* xp; const float* xs; float* out;
    __device__ __forceinline__ void operator()(const f32x4 (&acc)[2][2][4][2], const pg8::Unit& u, int wr, int wc, int fr, int fq) const {
        asm volatile("" : "+v"(fr), "+v"(fq));
        const float* src; float* dst;
        if (u.pm < 128) { src = xp + (size_t)u.pm * 256 * DM; dst = out + OFF_YP + (size_t)u.pm * 256 * DM; }
        else { src = xs; dst = out + OFF_YS; }
        const size_t base = (size_t)(wr * 64 + fr) * DM + u.pn * 256 + wc * 32 + 8 * fq;
        f32x4 xa[2][2][2], xb[2][2][2];
#define OUT_LD(xr_, c_) do { _Pragma("unroll") for (int mm = 0; mm < 2; ++mm) _Pragma("unroll") for (int bj = 0; bj < 2; ++bj) _Pragma("unroll") for (int n = 0; n < 2; ++n) \
            xr_[mm][bj][n] = *(const f32x4*)(src + base + (size_t)(((c_) >> 1) * 128 + (2 * ((c_) & 1) + mm) * 16) * DM + bj * 128 + 4 * n); } while (0)
#define OUT_ST(srcv, c_) do { _Pragma("unroll") for (int mm = 0; mm < 2; ++mm) _Pragma("unroll") for (int bj = 0; bj < 2; ++bj) _Pragma("unroll") for (int n = 0; n < 2; ++n) \
            *(f32x4*)(dst + base + (size_t)(((c_) >> 1) * 128 + (2 * ((c_) & 1) + mm) * 16) * DM + bj * 128 + 4 * n) = srcv[mm][bj][n] + acc[(c_) >> 1][bj][2 * ((c_) & 1) + mm][n]; } while (0)
        OUT_LD(xa, 0); OUT_LD(xb, 1); __builtin_amdgcn_sched_barrier(0);
        OUT_ST(xa, 0); __builtin_amdgcn_sched_barrier(0); OUT_LD(xa, 2); __builtin_amdgcn_sched_barrier(0);
        OUT_ST(xb, 1); __builtin_amdgcn_sched_barrier(0); OUT_LD(xb, 3); __builtin_amdgcn_sched_barrier(0);
        OUT_ST(xa, 2); __builtin_amdgcn_sched_barrier(0);
        OUT_ST(xb, 3); __builtin_amdgcn_sched_barrier(0);
#undef OUT_LD
#undef OUT_ST
    }
};

#define XB_TMO      128
#define XB_XCNT(j)  (256  + 64 * (j))
#define XB_XSUB(j)  (1280 + 64 * (j))
#define XB_XGEN(j)  (2304 + 64 * (j))
#define XB_TOP      3328
#define XB_TOPGEN   3392
#define XCD_BAR_WORDS 3456
#define XB_SPIN_CAP (1u << 18)
__device__ __forceinline__ unsigned xb_ld(unsigned* p)              { return __hip_atomic_load(p, __ATOMIC_RELAXED, __HIP_MEMORY_SCOPE_AGENT); }
__device__ __forceinline__ unsigned xb_add(unsigned* p, unsigned v) { return __hip_atomic_fetch_add(p, v, __ATOMIC_RELAXED, __HIP_MEMORY_SCOPE_AGENT); }
__device__ __forceinline__ unsigned xb_xcc_id() { return (unsigned)__builtin_amdgcn_s_getreg((3 << 11) | 20) & 0xFu; }
#define XB_SPIN(cond, bar) do { unsigned _sp = 0; while (cond) { __builtin_amdgcn_s_sleep(1); \
    if ((++_sp & 255u) == 0u) { if (xb_ld(&(bar)[XB_TMO])) break; if (_sp > XB_SPIN_CAP) { atomicAdd(&(bar)[XB_TMO], 1u); break; } } } } while (0)
struct XcdBarrier { unsigned* bar; unsigned x; volatile LAS unsigned* st; };
__device__ __forceinline__ XcdBarrier xcd_barrier_post(unsigned* bar, volatile LAS unsigned* st) {
    XcdBarrier b; b.bar = bar; b.x = xb_xcc_id(); b.st = st;
    if (threadIdx.x == 0) (void)xb_add(&bar[XB_XCNT(b.x)], 1u);
    return b;
}
__device__ __forceinline__ void xcd_barrier_complete(unsigned* bar, unsigned x, unsigned& nloc, unsigned& nx) {
    const unsigned G = gridDim.x * gridDim.y * gridDim.z;
    unsigned sum, cnt, mine, sp = 0u;
    for (;;) {
        sum = 0u; cnt = 0u; mine = 0u;
#pragma unroll
        for (unsigned j = 0; j < 16; ++j) { const unsigned c = xb_ld(&bar[XB_XCNT(j)]); sum += c; cnt += (c > 0u) ? 1u : 0u; mine = (j == x) ? c : mine; }
        if (sum == G) break;
        __builtin_amdgcn_s_sleep(1);
        if ((++sp & 255u) == 0u) { if (xb_ld(&bar[XB_TMO])) break; if (sp > XB_SPIN_CAP) { atomicAdd(&bar[XB_TMO], 1u); break; } }
    }
    nloc = mine > 0u ? mine : 1u; nx = cnt > 0u ? cnt : 1u;
}
__device__ __forceinline__ void xcd_barrier(const XcdBarrier& b) {
    asm volatile("s_waitcnt vmcnt(0)" ::: "memory");
    __syncthreads();
    if (threadIdx.x == 0) {
        unsigned* bar = b.bar;
        __builtin_amdgcn_s_waitcnt(0);
        unsigned nloc = b.st[0], nx = b.st[1];
        if (nloc == 0u) { xcd_barrier_complete(bar, b.x, nloc, nx); b.st[0] = nloc; b.st[1] = nx; }
        const unsigned old = xb_add(&bar[XB_XSUB(b.x)], 1u);
        const unsigned gen = old / nloc;
        if (old + 1u == (gen + 1u) * nloc) {
            __builtin_amdgcn_fence(__ATOMIC_RELEASE, "agent");
            asm volatile("s_waitcnt vmcnt(0)" ::: "memory");
            const unsigned og = xb_add(&bar[XB_TOP], 1u);
            const unsigned tg = og / nx;
            if (og + 1u == (tg + 1u) * nx) xb_add(&bar[XB_TOPGEN], 1u);
            else XB_SPIN(xb_ld(&bar[XB_TOPGEN]) == tg, bar);
            __builtin_amdgcn_fence(__ATOMIC_ACQUIRE, "agent");
            xb_add(&bar[XB_XGEN(b.x)], 1u);
            asm volatile("s_waitcnt vmcnt(0)" ::: "memory");
        } else {
            XB_SPIN(xb_ld(&bar[XB_XGEN(b.x)]) == gen, bar);
            __builtin_amdgcn_fence(__ATOMIC_ACQUIRE, "agent");
            asm volatile("s_waitcnt vmcnt(0)" ::: "memory");
        }
    }
    __syncthreads();
}

__device__ __forceinline__ float wave_sum(float v) {
#pragma unroll
    for (int o = 1; o < 64; o <<= 1) v += __shfl_xor(v, o);
    return v;
}
template <bool F8>
__device__ __forceinline__ void p0_transpose_item(const float* W, int N, bf16_t* WT, int ldt, int drow0, int drow1, int dcol, LAS float* scr, int k0, int n0, int lane, float wsc = 1.f) {
    f32x4 wv[8];
#pragma unroll
    for (int i = 0; i < 8; ++i) wv[i] = __builtin_nontemporal_load((const f32x4*)(W + (size_t)(k0 + 4 * i + (lane >> 4)) * N + n0 + 4 * (lane & 15)));
#pragma unroll
    for (int i = 0; i < 8; ++i) { LAS float* d = scr + (4 * i + (lane >> 4)) * 65 + 4 * (lane & 15); d[0] = wv[i][0]; d[1] = wv[i][1]; d[2] = wv[i][2]; d[3] = wv[i][3]; }
    LDS_WAIT(); asm volatile("" ::: "memory");
    const int c = lane & 3;
#pragma unroll
    for (int j = 0; j < 4; ++j) { const int n = (lane >> 2) + 16 * j; const LAS float* s = scr + (8 * c) * 65 + n;
        const int drow = (n < 32 ? drow0 : drow1) + (n & 31);
        if constexpr (F8) {
            int w0 = __builtin_amdgcn_cvt_pk_fp8_f32(s[0 * 65] * 64.f, s[1 * 65] * 64.f, 0, false); w0 = __builtin_amdgcn_cvt_pk_fp8_f32(s[2 * 65] * 64.f, s[3 * 65] * 64.f, w0, true);
            int w1 = __builtin_amdgcn_cvt_pk_fp8_f32(s[4 * 65] * 64.f, s[5 * 65] * 64.f, 0, false); w1 = __builtin_amdgcn_cvt_pk_fp8_f32(s[6 * 65] * 64.f, s[7 * 65] * 64.f, w1, true);
            *(u32x2*)((unsigned char*)WT + (size_t)drow * ldt + dcol + k0 + 8 * c) = (u32x2){(unsigned)w0, (unsigned)w1};
        } else {
            u32x4 o; o.x = cvtpk(s[0 * 65] * wsc, s[1 * 65] * wsc); o.y = cvtpk(s[2 * 65] * wsc, s[3 * 65] * wsc); o.z = cvtpk(s[4 * 65] * wsc, s[5 * 65] * wsc); o.w = cvtpk(s[6 * 65] * wsc, s[7 * 65] * wsc);
            *(u32x4*)(WT + (size_t)drow * ldt + dcol + k0 + 8 * c) = o; } }
    LDS_WAIT(); asm volatile("" ::: "memory");
}
__device__ __forceinline__ int w1_dst_row(int sb) {
    if (sb < 64) { const int region = sb >> 4, head = (sb & 15) >> 1, eh = sb & 1, qk = region >> 1, map = region & 1;
        return 256 * (qk * 4 + (head >> 1)) + eh * 128 + 32 * ((head & 1) * 2 + map); }
    if (sb < 128) return 256 * 8 + (sb - 64) * 32;
    if (sb < 160) { const int idx = sb - 128; return 256 * (16 + (idx >> 2)) + 32 * (idx & 3); }
    if (sb < 192) { const int idx = sb - 160; return 256 * (16 + (idx >> 2)) + 128 + 32 * (idx & 3); }
    return 256 * 24 + (sb - 192) * 32;
}

namespace att {
constexpr int SLOT = 16384;
constexpr int LDS_X = 0;
constexpr int AUX_WSF = AUX_OFF, AUX_LUT = AUX_OFF + 2048;
constexpr float THR = 8.f;
__device__ __forceinline__ int crow(int r, int hi) { return (r & 3) + 8 * (r >> 2) + 4 * hi; }
__device__ __forceinline__ void glds16(const void* gsrc, unsigned lds_dst) { unsigned keep;
    asm volatile("s_mov_b32 %0, m0\n\ts_mov_b32 m0, %2\n\ts_nop 0\n\tglobal_load_lds_dwordx4 %1, off\n\ts_mov_b32 m0, %0" : "=&s"(keep) : "v"(gsrc), "s"(lds_dst) : "memory"); }
__device__ __forceinline__ void glds16s(const void* sbase, unsigned voff, unsigned lds_dst) { unsigned keep;
    asm volatile("s_mov_b32 %0, m0\n\ts_mov_b32 m0, %3\n\ts_nop 0\n\tglobal_load_lds_dwordx4 %1, %2\n\ts_mov_b32 m0, %0" : "=&s"(keep) : "v"(voff), "s"(sbase), "s"(lds_dst) : "memory"); }
template <int N> __device__ __forceinline__ float dpp_ror(float v) { return __uint_as_float(__builtin_amdgcn_update_dpp(0u, __float_as_uint(v), 0x120 + N, 0xf, 0xf, false)); }
__device__ __forceinline__ float max3f(float a, float b, float c) { float r; asm("v_max3_f32 %0, %1, %2, %3" : "=v"(r) : "v"(a), "v"(b), "v"(c)); return r; }
#define SBAR() __builtin_amdgcn_sched_barrier(0)
__device__ __forceinline__ s16x4 vtr(const LAS unsigned char* p) { return __builtin_bit_cast(s16x4, __builtin_amdgcn_ds_read_tr16_b64_v4i16((LAS s16x4*)p)); }

struct Tensors {
    const bf16_t *Qb, *Qs, *Kb, *Vb, *Kmb, *Vmb, *Ksb, *Vsb, *Kcb, *Vcb, *ZA; bf16_t* CA;
    const float* rel_bias; const float* slg;
};

__device__ __forceinline__ void attn_unit(const Tensors& T, const int sample, const int b, const int h, const int j, LAS unsigned char* lds, const float lam) {
    const int tid = threadIdx.x, lane = tid & 63, r32 = lane & 31, hi = lane >> 5;
    const int wid = __builtin_amdgcn_readfirstlane(tid >> 6), map = wid >> 2, g = wid & 3;
    const int bh = b * NH + h;
    LAS float* wsf = (LAS float*)(lds + AUX_WSF) + wid * 64;
    LAS float* lut = (LAS float*)(lds + AUX_LUT);
    if (tid < 192) {
        const int rel = tid - 128, n = rel < 0 ? -rel : rel;
        const int bk = n < 8 ? n : min(15, 2 + (31 - __clz(n * n)));
        const int bucket = (rel > 0 ? 16 : 0) + bk;
        lut[tid] = (T.rel_bias[bucket * NH + h] - T.rel_bias[15 * NH + h]) * LOG2E;
    }
    const int NT = sample ? 17 : 2 * j + 3;
    const bool act_all = sample ? (g == 0) : true;
    const bool act_last = sample ? (g == 0) : (g >= 2);
    const int qpos0 = sample ? PAST : NMETA + 128 * j + 32 * g;
    bf16x8 qr[4];
    {
        const bf16_t* qp = sample ? T.Qs + ((size_t)bh * SS + r32) * 128 : T.Qb + ((size_t)bh * SEQ + 128 * j + 32 * g + r32) * 128;
        qp += map * 64 + hi * 8;
#pragma unroll
        for (int d0 = 0; d0 < 4; ++d0) qr[d0] = *(const bf16x8*)(qp + d0 * 16);
    }
    f32x16 o[4]; o[0] = f32x16{}; o[1] = f32x16{}; o[2] = f32x16{}; o[3] = f32x16{};
    f32x16 ol = f32x16{};
    const f32x16 zero16 = f32x16{};
    const bf16x8 ones8 = (bf16x8){0x3F80, 0x3F80, 0x3F80, 0x3F80, 0x3F80, 0x3F80, 0x3F80, 0x3F80};
    auto tile_k = [&](int it) -> const bf16_t* {
        if (sample) return it < 16 ? T.Kcb + ((size_t)bh * 16 + it) * 8192 : T.Ksb + (size_t)bh * 8192;
        return it == 0 ? T.Kmb + (size_t)h * 8192 : T.Kb + ((size_t)bh * 32 + (it - 1)) * 8192;
    };
    auto tile_v = [&](int it) -> const bf16_t* {
        if (sample) return it < 16 ? T.Vcb + ((size_t)bh * 16 + it) * 8192 : T.Vsb + (size_t)bh * 8192;
        return it == 0 ? T.Vmb + (size_t)h * 8192 : T.Vb + ((size_t)bh * 32 + (it - 1)) * 8192;
    };
#define ATT_DMA(t, slot) do { const bf16_t* kp_ = tile_k(t); const bf16_t* vp_ = tile_v(t); \
        _Pragma("unroll") for (int i_ = 0; i_ < 2; ++i_) { \
            glds16s(kp_ + (2 * wid + i_) * 512, lane16, (unsigned)__builtin_amdgcn_readfirstlane(lds0 + (slot) * 32768 + (2 * wid + i_) * 1024)); \
            glds16s(vp_ + (2 * wid + i_) * 512, lane16, (unsigned)__builtin_amdgcn_readfirstlane(lds0 + (slot) * 32768 + SLOT + (2 * wid + i_) * 1024)); } } while (0)
    const unsigned lane16 = (unsigned)lane * 16u;
    const unsigned lds0 = (unsigned)(uintptr_t)lds;
    asm volatile("s_waitcnt vmcnt(0)" :: "v"(qr[0]), "v"(qr[1]), "v"(qr[2]), "v"(qr[3]) : "memory");
    ATT_DMA(0, 0); ATT_DMA(1, 1); ATT_DMA(2, 2);
    const int vlane = ((lane >> 4) & 1) * 32 + (lane & 3) * 8 + (4 * hi + ((lane & 15) >> 2)) * 64;
    for (int it = 0; it < NT; ++it) {
        const int so = (it & 3) * 32768;
        asm volatile("s_waitcnt vmcnt(8)" ::: "memory"); __builtin_amdgcn_s_barrier(); asm volatile("" ::: "memory");
        { const int tn = it + 3 < NT ? it + 3 : 0; ATT_DMA(tn, (it + 3) & 3); }
        const bool active = (it == NT - 1) ? act_last : act_all;
        if (active) {
            int kpos0, nvalid;
            if (sample) { kpos0 = 64 * it; nvalid = it < 16 ? 64 : 16; } else { kpos0 = it == 0 ? 0 : NMETA + 64 * (it - 1); nvalid = it == 0 ? 16 : 64; }
            f32x16 p0, p1;
            { const LAS unsigned char* kb = lds + so + map * 8192 + hi * 1024 + r32 * 16;
              bf16x8 kf[8];
#pragma unroll
              for (int d0 = 0; d0 < 4; ++d0) { kf[2 * d0] = *(const LAS bf16x8*)(kb + d0 * 2048); kf[2 * d0 + 1] = *(const LAS bf16x8*)(kb + d0 * 2048 + 512); }
              SBAR();
              p0 = __builtin_amdgcn_mfma_f32_32x32x16_bf16(kf[0], qr[0], zero16, 0, 0, 0); p1 = __builtin_amdgcn_mfma_f32_32x32x16_bf16(kf[1], qr[0], zero16, 0, 0, 0);
#pragma unroll
              for (int d0 = 1; d0 < 4; ++d0) { p0 = __builtin_amdgcn_mfma_f32_32x32x16_bf16(kf[2 * d0], qr[d0], p0, 0, 0, 0); p1 = __builtin_amdgcn_mfma_f32_32x32x16_bf16(kf[2 * d0 + 1], qr[d0], p1, 0, 0, 0); } }
            SBAR();
            const LAS unsigned char* vb = lds + so + SLOT + vlane;
            s16x4 va[8], vbb[8];
#define ATT_VRD(dst, db) do { _Pragma("unroll") for (int s_ = 0; s_ < 4; ++s_) { dst[2 * s_] = vtr(vb + (db) * 4096 + s_ * 1024); dst[2 * s_ + 1] = vtr(vb + (db) * 4096 + s_ * 1024 + 512); } } while (0)
#define ATT_VF(src, s_) ((bf16x8){src[2 * (s_)][0], src[2 * (s_)][1], src[2 * (s_)][2], src[2 * (s_)][3], src[2 * (s_) + 1][0], src[2 * (s_) + 1][1], src[2 * (s_) + 1][2], src[2 * (s_) + 1][3]})
            ATT_VRD(va, 0);
            SBAR();
            if (kpos0 + 63 - qpos0 > -128) {
                const int rb = kpos0 - (qpos0 + r32) + 128 + 4 * hi;
#pragma unroll
                for (int r = 0; r < 16; ++r) { const int i0 = rb + (r & 3) + 8 * (r >> 2); const int i1 = i0 + 32;
                    p0[r] += lut[min(max(i0, 0), 191)]; p1[r] += lut[min(max(i1, 0), 191)]; }
            }
            if (nvalid < 64) {
#pragma unroll
                for (int r = 0; r < 16; ++r) { if ((r & 3) + 8 * (r >> 2) + 4 * hi >= nvalid) p0[r] = -INFINITY; p1[r] = -INFINITY; }
            }
#pragma unroll
            for (int r = 0; r < 16; ++r) { p0[r] = __builtin_amdgcn_exp2f(p0[r]); p1[r] = __builtin_amdgcn_exp2f(p1[r]); }
            bf16x8 pa[4];
            { u32x4 w;
              w.x = cvtpk(p0[0], p0[1]); w.y = cvtpk(p0[2], p0[3]); w.z = cvtpk(p0[4], p0[5]); w.w = cvtpk(p0[6], p0[7]); pa[0] = __builtin_bit_cast(bf16x8, w);
              w.x = cvtpk(p0[8], p0[9]); w.y = cvtpk(p0[10], p0[11]); w.z = cvtpk(p0[12], p0[13]); w.w = cvtpk(p0[14], p0[15]); pa[1] = __builtin_bit_cast(bf16x8, w);
              w.x = cvtpk(p1[0], p1[1]); w.y = cvtpk(p1[2], p1[3]); w.z = cvtpk(p1[4], p1[5]); w.w = cvtpk(p1[6], p1[7]); pa[2] = __builtin_bit_cast(bf16x8, w);
              w.x = cvtpk(p1[8], p1[9]); w.y = cvtpk(p1[10], p1[11]); w.z = cvtpk(p1[12], p1[13]); w.w = cvtpk(p1[14], p1[15]); pa[3] = __builtin_bit_cast(bf16x8, w); }
            SBAR();
#pragma unroll
            for (int s_ = 0; s_ < 4; ++s_) ol = __builtin_amdgcn_mfma_f32_32x32x16_bf16(pa[s_], ones8, ol, 0, 0, 0);
#define ATT_PV(db, cur) do { _Pragma("unroll") for (int s_ = 0; s_ < 4; ++s_) o[db] = __builtin_amdgcn_mfma_f32_32x32x16_bf16(pa[s_], ATT_VF(cur, s_), o[db], 0, 0, 0); } while (0)
            ATT_VRD(vbb, 1); SBAR(); ATT_PV(0, va); SBAR();
            ATT_VRD(va, 2);  SBAR(); ATT_PV(1, vbb); SBAR();
            ATT_VRD(vbb, 3); SBAR(); ATT_PV(2, va); SBAR();
            ATT_PV(3, vbb); SBAR();
#undef ATT_VRD
#undef ATT_VF
#undef ATT_PV
        }
    }
    asm volatile("s_waitcnt vmcnt(0) lgkmcnt(0)" ::: "memory");
    __syncthreads();
    const bool fin = sample ? (g == 0) : true;
    LAS float* xr = (LAS float*)(lds + LDS_X + g * 16384);
    const int ch = lane & 15;
    const int nq = sample ? 16 : 32;
    const size_t row0 = sample ? (size_t)ROW_S + b * SS : (size_t)b * SEQ + 128 * j + 32 * g;
    u32x4 zv[8];
    if (fin && map == 0) {
#pragma unroll
        for (int i = 0; i < 8; ++i) { const int q = min(i * 4 + (lane >> 4), nq - 1); zv[i] = *(const u32x4*)(T.ZA + (row0 + q) * CC + h * 128 + ch * 8); }
    }
    if (fin && map == 1) {
        const float sc = -lam;
#pragma unroll
        for (int r = 0; r < 16; ++r) { const float rl = __builtin_amdgcn_rcpf(ol[r]) * sc;
#pragma unroll
            for (int db = 0; db < 4; ++db) xr[(db * 16 + r) * 64 + lane] = o[db][r] * rl; }
    }
    LDS_WAIT();
    __syncthreads();
    if (fin && map == 0) {
        float ssq[16];
#pragma unroll
        for (int r = 0; r < 16; ++r) { const float rl = __builtin_amdgcn_rcpf(ol[r]); float s2 = 0.f;
#pragma unroll
            for (int db = 0; db < 4; ++db) { const float v = o[db][r] * rl + xr[(db * 16 + r) * 64 + lane]; o[db][r] = v; s2 += v * v; }
            ssq[r] = s2; }
#pragma unroll
        for (int r = 0; r < 16; ++r) { float s2 = ssq[r];
            s2 += dpp_ror<8>(s2); s2 += dpp_ror<4>(s2); s2 += dpp_ror<2>(s2); s2 += dpp_ror<1>(s2);
            { auto rr = __builtin_amdgcn_permlane16_swap(__float_as_uint(s2), __float_as_uint(s2), false, false); s2 = __uint_as_float(rr[0]) + __uint_as_float(rr[1]); }
            ssq[r] = __builtin_amdgcn_rsqf(s2 * (1.f / 128.f) + EPS) * 0.8f; }
        LDS_WAIT();
        LAS bf16_t* stg = (LAS bf16_t*)xr;
#pragma unroll
        for (int r = 0; r < 16; ++r) { const int q = crow(r, hi);
#pragma unroll
            for (int db = 0; db < 4; ++db) stg[q * 136 + db * 32 + r32] = (bf16_t)(cvtpk(o[db][r] * ssq[r], 0.f) & 0xffffu); }
        LDS_WAIT();
        const f32x4 g0 = *(const f32x4*)(T.slg + ch * 8), g1 = *(const f32x4*)(T.slg + ch * 8 + 4);
#pragma unroll
        for (int i = 0; i < 8; ++i) {
            const int q = i * 4 + (lane >> 4);
            if (q < nq) {
                const u32x4 w = *(const LAS u32x4*)(stg + q * 136 + ch * 8);
                const u32x4 z = zv[i];
                u32x4 ow;
                ow.x = cvtpk(bflo(w.x) * g0[0] * bflo(z.x), bfhi(w.x) * g0[1] * bfhi(z.x)); ow.y = cvtpk(bflo(w.y) * g0[2] * bflo(z.y), bfhi(w.y) * g0[3] * bfhi(z.y));
                ow.z = cvtpk(bflo(w.z) * g1[0] * bflo(z.z), bfhi(w.z) * g1[1] * bfhi(z.z)); ow.w = cvtpk(bflo(w.w) * g1[2] * bflo(z.w), bfhi(w.w) * g1[3] * bfhi(z.w));
                *(u32x4*)(T.CA + (row0 + q) * DM + CC + h * 128 + ch * 8) = ow;
            }
        }
    }
    LDS_WAIT();
    __syncthreads();
}
}

struct ConvT { const bf16_t *GLU, *ZC; bf16_t* CA; };
struct ConvW { f32x2 W[CW]; f32x2 bias, gg, bb; };
__device__ __forceinline__ void conv_unit(const ConvT& T, const ConvW& P, int cu, LAS unsigned char* lds) {
    const int tid = threadIdx.x, lane = tid & 63, wid = __builtin_amdgcn_readfirstlane(tid >> 6);
    const int c2 = 2 * tid;
    const bool sample = cu >= 1024;
    const int b = sample ? cu - 1024 : cu >> 6, t0 = sample ? 0 : (cu & 63) * 32;
    const bf16_t* gin = T.GLU + (sample ? (size_t)GLU_S0 + b * GLU_SB : (size_t)b * GLU_PB + NMETA + t0) * CC + c2;
    const f32x2 (&W)[CW] = P.W; const f32x2 bias = P.bias;
    f32x2 acc[32];
#pragma unroll
    for (int o = 0; o < 32; ++o) acc[o] = bias;
    unsigned wa[16], wb[16];
#define CONV_LOAD(dst, i0) do { _Pragma("unroll") for (int k = 0; k < 16; ++k) if ((i0) + k < 62) dst[k] = *(const unsigned*)(gin + (size_t)((i0) + k) * CC); } while (0)
#define CONV_FMA(src, i0) do { _Pragma("unroll") for (int k = 0; k < 16; ++k) { const int i = (i0) + k; if (i < 62) { const f32x2 v = (f32x2){bflo(src[k]), bfhi(src[k])}; \
        _Pragma("unroll") for (int o = 0; o < 32; ++o) { const int w = i - o; if (w >= 0 && w < CW) acc[o] += v * W[w]; } } } } while (0)
    CONV_LOAD(wa, 0); CONV_LOAD(wb, 16);
    __builtin_amdgcn_sched_barrier(0);
    CONV_FMA(wa, 0);
    __builtin_amdgcn_sched_barrier(0);
    CONV_LOAD(wa, 32);
    __builtin_amdgcn_sched_barrier(0);
    CONV_FMA(wb, 16);
    __builtin_amdgcn_sched_barrier(0);
    CONV_LOAD(wb, 48);
    __builtin_amdgcn_sched_barrier(0);
    CONV_FMA(wa, 32);
    __builtin_amdgcn_sched_barrier(0);
    CONV_FMA(wb, 48);
#undef CONV_LOAD
#undef CONV_FMA
    const int nout = sample ? 16 : 32;
    const size_t row0 = sample ? (size_t)ROW_S + b * SS : (size_t)b * SEQ + t0;
    float s1[32], s2[32];
#pragma unroll
    for (int o = 0; o < 32; ++o) { s1[o] = acc[o].x + acc[o].y; s2[o] = acc[o].x * acc[o].x + acc[o].y * acc[o].y; }
#pragma unroll
    for (int step = 0; step < 5; ++step) {
        const int half = 16 >> step, bit = 32 >> step; const bool up = (lane & bit) != 0;
#pragma unroll
        for (int k = 0; k < half; ++k) {
            const float send1 = up ? s1[k] : s1[k + half], keep1 = up ? s1[k + half] : s1[k];
            const float send2 = up ? s2[k] : s2[k + half], keep2 = up ? s2[k + half] : s2[k];
            s1[k] = keep1 + __shfl_xor(send1, bit); s2[k] = keep2 + __shfl_xor(send2, bit);
        }
    }
    s1[0] += __shfl_xor(s1[0], 1); s2[0] += __shfl_xor(s2[0], 1);
    LAS float* red = (LAS float*)(lds);
    LAS float* stat = (LAS float*)(lds + 2048);
    if ((lane & 1) == 0) { red[(wid * 32 + (lane >> 1)) * 2] = s1[0]; red[(wid * 32 + (lane >> 1)) * 2 + 1] = s2[0]; }
    LDS_WAIT();
    __syncthreads();
    if (tid < 32) { float a = 0.f, q = 0.f;
#pragma unroll
        for (int w = 0; w < 8; ++w) { a += red[(w * 32 + tid) * 2]; q += red[(w * 32 + tid) * 2 + 1]; }
        const float mean = a * (1.f / CC); const float var = fmaxf(q * (1.f / CC) - mean * mean, 0.f);
        stat[tid * 2] = mean; stat[tid * 2 + 1] = __builtin_amdgcn_rsqf(var + EPS); }
    LDS_WAIT();
    __syncthreads();
    const f32x2 gg = P.gg, bb = P.bb;
    unsigned zc[32];
#pragma unroll
    for (int o = 0; o < 32; ++o) zc[o] = *(const unsigned*)(T.ZC + (row0 + min(o, nout - 1)) * CC + c2);
    __builtin_amdgcn_sched_barrier(0);
#pragma unroll
    for (int o = 0; o < 32; ++o) {
        if (o < nout) {
            const float mean = stat[o * 2], rstd = stat[o * 2 + 1];
            const f32x2 y = (acc[o] - mean) * rstd * gg + bb;
            const unsigned z = zc[o];
            *(unsigned*)(T.CA + (row0 + o) * DM + c2) = cvtpk(siluf_(y.x) * bflo(z), siluf_(y.y) * bfhi(z));
        }
    }
    LDS_WAIT();
    __syncthreads();
}

template <int KSTEPS>
__device__ __forceinline__ f32x4 mini_dot(const bf16_t* arow, const bf16_t* brow) {
    f32x4 acc = (f32x4){0.f, 0.f, 0.f, 0.f};
    bf16x8 a[8], b[8];
#pragma unroll
    for (int u = 0; u < 8; ++u) { a[u] = *(const bf16x8*)(arow + 32 * u); b[u] = *(const bf16x8*)(brow + 32 * u); }
    for (int k0 = 0; k0 < KSTEPS; k0 += 8) {
#pragma unroll
        for (int u = 0; u < 8; ++u) {
            acc = __builtin_amdgcn_mfma_f32_16x16x32_bf16(b[u], a[u], acc, 0, 0, 0);
            if (k0 + 8 < KSTEPS) { a[u] = *(const bf16x8*)(arow + 32 * (k0 + 8 + u)); b[u] = *(const bf16x8*)(brow + 32 * (k0 + 8 + u)); }
        }
    }
    return acc;
}
__device__ __forceinline__ void side_p3(const bf16_t* CA, const bf16_t* WBT, const bf16_t* GC, const bf16_t* GA, bf16_t* MG, int vcu) {
    const int tid = threadIdx.x, lane = tid & 63, wid = tid >> 6, fr = lane & 15, fq = lane >> 4;
    const int rh = vcu & 1, c0 = (vcu >> 1) * 16;
    const size_t row = (size_t)ROW_S + rh * 128 + wid * 16 + fr;
    const bf16_t* ar = CA + row * DM + 8 * fq; const bf16_t* br = WBT + (size_t)(c0 + fr) * DM + 8 * fq;
    const f32x4 x0 = mini_dot<32>(ar, br), x1 = mini_dot<32>(ar + CC, br + CC);
    const size_t off = row * DM + c0 + 4 * fq;
    const f32x4 gc = unpack_u8x4(*(const unsigned*)((const unsigned char*)GC + off)) * (1.f / 255.f), ga = unpack_u8x4(*(const unsigned*)((const unsigned char*)GA + off)) * (1.f / 255.f);
    u32x2 o; o.x = cvtpk(gc[0] * x0[0] + ga[0] * x1[0], gc[1] * x0[1] + ga[1] * x1[1]); o.y = cvtpk(gc[2] * x0[2] + ga[2] * x1[2], gc[3] * x0[3] + ga[3] * x1[3]);
    *(u32x2*)(MG + off) = o;
}
__device__ __forceinline__ void side_p4(const bf16_t* MG, const bf16_t* WOT, const float* xs, float* ys, int vcu) {
    const int tid = threadIdx.x, lane = tid & 63, wid = tid >> 6, fr = lane & 15, fq = lane >> 4;
    const int rh = vcu & 1, c0 = (vcu >> 1) * 16;
    const int r = rh * 128 + wid * 16 + fr;
    const f32x4 acc = mini_dot<64>(MG + ((size_t)ROW_S + r) * DM + 8 * fq, WOT + (size_t)(c0 + fr) * DM + 8 * fq);
    const size_t off = (size_t)r * DM + c0 + 4 * fq;
    *(f32x4*)(ys + off) = *(const f32x4*)(xs + off) + acc;
}

__global__ void __launch_bounds__(NWAVES * 64, 2) fwd_kernel(Args args) {
    extern __shared__ __attribute__((aligned(16))) unsigned char lds_raw[];
    LAS unsigned char* lds = (LAS unsigned char*)lds_raw;
    volatile LAS unsigned* MISC = (volatile LAS unsigned*)(lds + MISC_OFF);
    const int tid = threadIdx.x, lane = tid & 63, wave = __builtin_amdgcn_readfirstlane(tid >> 6);
    const int G = gridDim.x; const int bx = blockIdx.x; const int vcu = (G % 8 == 0) ? (bx % 8) * (G / 8) + bx / 8 : bx;
    unsigned char* ws = args.ws;
    unsigned* ctl = (unsigned*)(ws + WS_CTL);
    for (int u = tid; u < (LDS_BYTES - LDSCTL_OFF) / 4; u += NWAVES * 64) ((LAS unsigned*)(lds + LDSCTL_OFF))[u] = 0u;
    __syncthreads();
    XcdBarrier bar = xcd_barrier_post(ctl + CW_BAR + args.li * XCD_BAR_WORDS, MISC + 8);
    const int lo = args.ph_lo, hi = args.ph_hi;
#ifndef PH_MASK
#define PH_MASK 31
#endif
#define IN(k) (((PH_MASK >> (k)) & 1) && lo <= (k) && (k) < hi)
#define BOTH(k) (IN(k) && IN((k) + 1))

    bf16_t* W1T = (bf16_t*)(ws + WS_W1T); bf16_t* WBT = (bf16_t*)(ws + WS_WBT); bf16_t* WOT = (bf16_t*)(ws + WS_WOT);
    bf16_t* Hb = (bf16_t*)(ws + WS_H); bf16_t* CA = (bf16_t*)(ws + WS_CA); bf16_t* MG = (bf16_t*)(ws + WS_MG);
    bf16_t* Qb = (bf16_t*)(ws + WS_QB); bf16_t* Kb = (bf16_t*)(ws + WS_KB); bf16_t* Vb = (bf16_t*)(ws + WS_VB);
    bf16_t* Kmb = (bf16_t*)(ws + WS_KMB); bf16_t* Vmb = (bf16_t*)(ws + WS_VMB); bf16_t* Ksb = (bf16_t*)(ws + WS_KSB); bf16_t* Vsb = (bf16_t*)(ws + WS_VSB); bf16_t* Qs = (bf16_t*)(ws + WS_QS);
    bf16_t* ZA = (bf16_t*)(ws + WS_ZA); bf16_t* GLU = (bf16_t*)(ws + WS_GLU); bf16_t* ZC = (bf16_t*)(ws + WS_ZC); bf16_t* GC = (bf16_t*)(ws + WS_GC); bf16_t* GA = (bf16_t*)(ws + WS_GA);
    bf16_t* Kcb = (bf16_t*)(ws + WS_KCB); bf16_t* Vcb = (bf16_t*)(ws + WS_VCB);
    unsigned char* H8 = ws + WS_H8; unsigned char* W8 = ws + WS_W8;

    if (IN(0)) {
        const int gw = vcu * NWAVES + wave, NGW = G * NWAVES;
        LAS float* scr = (LAS float*)(lds + wave * 16384);
        for (int it = gw; it < 2 * 128 * 16; it += NGW) {
            const int kv = it & 1, tile = it >> 1;
            const float* src = (kv ? args.in[I_CV] : args.in[I_CK]) + (size_t)tile * 64 * 128;
            bf16_t* dst = (kv ? Vcb : Kcb) + (size_t)tile * 8192;
#pragma unroll 4
            for (int i = 0; i < 16; ++i) {
                const int p = i * 64 + lane, key = p >> 4, dc = p & 15;
                const f32x4 a = __builtin_nontemporal_load((const f32x4*)(src + key * 128 + dc * 8)), c = __builtin_nontemporal_load((const f32x4*)(src + key * 128 + dc * 8 + 4));
                const int off = kv ? ((dc >> 2) * 2048 + (key >> 4) * 512 + (key & 15) * 32 + (dc & 3) * 8) : (dc * 512 + key * 8);
                *(u32x4*)(dst + off) = pack8(a, c);
            }
        }
        constexpr int I_1 = 64 * 176, I_B = 2 * 32 * 32, I_O = 64 * 32;
        for (int it = gw; it < I_1 + I_B + I_O; it += NGW) {
            int r = it;
            if (r < I_1) { const int kb = r / 176, nb = r % 176;
                if (nb >= 112) p0_transpose_item<true>(args.in[I_WIN], DIN, (bf16_t*)W8, DM, (2 * nb - 224) * 32, (2 * nb - 223) * 32, 0, scr, 32 * kb, 64 * nb, lane);
                else p0_transpose_item<false>(args.in[I_WIN], DIN, W1T, DM, w1_dst_row(2 * nb), w1_dst_row(2 * nb + 1), 0, scr, 32 * kb, 64 * nb, lane);
                continue; }
            r -= I_1;
            if (r < I_B) { const int br = r / 1024, rr = r % 1024, kb = rr / 32, nb = rr % 32; p0_transpose_item<false>(args.in[I_WB] + (size_t)br * CC * DM, DM, WBT, DM, 64 * nb, 64 * nb + 32, br * CC, scr, 32 * kb, 64 * nb, lane); continue; }
            r -= I_B;
            { const int kb = r / 32, nb = r % 32; p0_transpose_item<false>(args.in[I_WO], DM, WOT, DM, 64 * nb, 64 * nb + 32, 0, scr, 32 * kb, 64 * nb, lane); }
        }
        {
            f32x4 gv[8];
#pragma unroll
            for (int jj = 0; jj < 8; ++jj) gv[jj] = *((const f32x4*)args.in[I_NG] + lane + 64 * jj);
            for (int m = gw; m < MROWS; m += NGW) {
                u32x2* o8 = (u32x2*)(Hb + (size_t)m * DM) + lane;
                unsigned* o4 = (unsigned*)(H8 + (size_t)m * DM) + lane;
                if (m >= ROW_M + NMETA) {
#pragma unroll
                    for (int jj = 0; jj < 8; ++jj) { o8[64 * jj] = (u32x2){0u, 0u}; o4[64 * jj] = 0u; }
                    continue;
                }
                const float* xrow = m < ROW_S ? args.in[I_XP] + (size_t)m * DM : (m < ROW_M ? args.in[I_XS] + (size_t)(m - ROW_S) * DM : args.in[I_META] + (size_t)(m - ROW_M) * DM);
                const f32x4* xr = (const f32x4*)xrow + lane;
                f32x4 v[8]; float s = 0.f;
#pragma unroll
                for (int jj = 0; jj < 8; ++jj) { v[jj] = __builtin_nontemporal_load(xr + 64 * jj); s += (v[jj][0] * v[jj][0] + v[jj][1] * v[jj][1]) + (v[jj][2] * v[jj][2] + v[jj][3] * v[jj][3]); }
                const float rs = __builtin_amdgcn_rsqf(wave_sum(s) * (1.f / DM) + EPS);
#pragma unroll
                for (int jj = 0; jj < 8; ++jj) { const f32x4 y = v[jj] * gv[jj] * rs; o8[64 * jj] = (u32x2){cvtpk(y[0], y[1]), cvtpk(y[2], y[3])};
                    int w8 = __builtin_amdgcn_cvt_pk_fp8_f32(y[0], y[1], 0, false); w8 = __builtin_amdgcn_cvt_pk_fp8_f32(y[2], y[3], w8, true); o4[64 * jj] = (unsigned)w8; }
            }
        }
        {
            const int gt = vcu * (NWAVES * 64) + tid, NGT = G * NWAVES * 64; const u32x4 z = (u32x4){0u, 0u, 0u, 0u};
            for (int i = gt; i < 2 * 8 * 1024; i += NGT) ((u32x4*)Kmb)[i] = z;
            for (int i = gt; i < 2 * 128 * 1024; i += NGT) ((u32x4*)Ksb)[i] = z;
            for (int i = gt; i < 256; i += NGT) ((u32x4*)(Qs + (size_t)128 * SS * 128))[i] = z;
            for (int i = gt; i < NB * 30 * 128; i += NGT) { const int b = i / (30 * 128), r = i % (30 * 128); ((u32x4*)(GLU + (size_t)b * GLU_PB * CC))[r] = z; }
            for (int i = gt; i < 32 * 128; i += NGT) ((u32x4*)(GLU + (size_t)(GLU_S0 + SB * GLU_SB) * CC))[i] = z;
            for (int i = gt; i < SB * 30 * 128; i += NGT) { const int b = i / (30 * 128), r = i % (30 * 128); const float* sp = args.in[I_SC] + (size_t)b * 30 * CC + r * 8;
                ((u32x4*)(GLU + (size_t)(GLU_S0 + b * GLU_SB) * CC))[r] = pack8(*(const f32x4*)sp, *(const f32x4*)(sp + 4)); }
            for (int i = gt; i < SB * 14 * CC / 4; i += NGT) { const int b = i / (14 * CC / 4), r = i % (14 * CC / 4);
                ((f32x4*)(args.out + OFF_CS + (size_t)b * 30 * CC))[r] = ((const f32x4*)(args.in[I_SC] + ((size_t)b * 30 + 16) * CC))[r]; }
        }
        if (BOTH(0)) xcd_barrier(bar);
    }

    if (IN(1)) {
#ifndef NSTAT_A
#define NSTAT_A 11
#define NSTAT_B 5
#endif
        LAS unsigned* qmail = (LAS unsigned*)(lds + MISC_OFF + 64);
        const int qx = bx & 7, qslot = bx >> 3, qns = (G % 8 == 0) ? G / 8 : 0;
        { pg8::Gemm g{Hb, W1T, DM, DM, DM}; SchedIn S{{ctl + CW_GQ, qmail, qx, qslot, qns, 129 * 28 + 16, qns ? NSTAT_A : 0}};
          EpiIn E{args.out, args.in[I_QG], args.in[I_KG], Qb, Qs, Kb, Vb, Kmb, Vmb, Ksb, Vsb, ZA, GLU, ZC, GC, GA, 0};
          pg8::gemm_phase<EpiIn, SchedIn, true, false, true>(lds, g, S, E); }
        { pg8::Gemm g{(const bf16_t*)H8, (const bf16_t*)W8, DM / 2, DM / 2, DM / 2}; SchedGate S{{ctl + CW_GQ + 512, qmail, qx, qslot, qns, 129 * 16, qns ? NSTAT_B : 0}};
          EpiGate E{GC, GA};
          pg8::gemm_phase<EpiGate, SchedGate, true, true, true>(lds, g, S, E); }
        if (BOTH(1)) xcd_barrier(bar);
    }

    if (IN(2)) {
        float lam;
        { const float* lq = args.in[I_LQK]; const float a = wave_sum(lq[lane] * lq[64 + lane]), c = wave_sum(lq[128 + lane] * lq[192 + lane]); lam = __expf(a) - __expf(c) + 0.2f; }
        att::Tensors T{Qb, Qs, Kb, Vb, Kmb, Vmb, Ksb, Vsb, Kcb, Vcb, ZA, CA, args.in[I_RB], args.in[I_SLG]};
        for (int q = vcu; q < 2048; q += G) {
            const int i = q >> 8, v = q & 255, bh = v >> 1, p = v & 1, s = 4 * p + (i >> 1), j = (i & 1) ? 15 - s : s;
            att::attn_unit(T, 0, bh >> 3, bh & 7, j, lds, lam);
        }
        ConvT C{GLU, ZC, CA};
        LAS unsigned* qw = (LAS unsigned*)(lds + AUX_OFF + 3072);
        for (;;) {
            if (tid == 0) qw[0] = __hip_atomic_fetch_add(ctl + CW_Q, 1u, __ATOMIC_RELAXED, __HIP_MEMORY_SCOPE_AGENT);
            __syncthreads();
            const int item = (int)qw[0];
            __syncthreads();
            if (item >= 128) break;
            att::attn_unit(T, 1, item >> 3, item & 7, 0, lds, lam);
        }
        ConvW CP;
        { const int c2 = 2 * tid;
#pragma unroll
          for (int w = 0; w < CW; ++w) CP.W[w] = *(const f32x2*)(args.in[I_CWT] + w * CC + c2);
          CP.bias = *(const f32x2*)(args.in[I_CB] + c2); CP.gg = *(const f32x2*)(args.in[I_LNG] + c2); CP.bb = *(const f32x2*)(args.in[I_LNB] + c2); }
        for (;;) {
            if (tid == 0) qw[0] = __hip_atomic_fetch_add(ctl + CW_Q + 64, 1u, __ATOMIC_RELAXED, __HIP_MEMORY_SCOPE_AGENT);
            __syncthreads();
            const int item = (int)qw[0];
            __syncthreads();
            if (item >= 1024 + SB) break;
            conv_unit(C, CP, item, lds);
        }
        if (BOTH(2)) xcd_barrier(bar);
    }

    if (IN(3)) {
        for (int v = vcu; v < 256; v += G) side_p3(CA, WBT, GC, GA, MG, v);
        pg8::Gemm g{CA, WBT, DM, DM, DM}; SchedBr S{G, bx}; EpiBr E{GC, GA, MG};
        pg8::gemm_phase<EpiBr, SchedBr, true>(lds, g, S, E);
        if (BOTH(3)) xcd_barrier(bar);
    }

    if (IN(4)) {
        for (int v = vcu; v < 256; v += G) side_p4(MG, WOT, args.in[I_XS], args.out + OFF_YS, v);
        pg8::Gemm g{MG, WOT, DM, DM, DM}; SchedOut S{G, bx}; EpiOut E{args.in[I_XP], args.in[I_XS], args.out};
        pg8::gemm_phase<EpiOut, SchedOut, true>(lds, g, S, E);
    }
#undef IN
#undef BOTH
}

extern "C" void kernel_launch(void* const* d_in, const int* in_sizes, int n_in, void* d_out, int out_size, void* d_ws, size_t ws_size, hipStream_t stream) {
    static int grid = 0;
    if (grid == 0) {
        if (n_in != 19 || (size_t)out_size != OUT_TOTAL || ws_size < WS_END) { fprintf(stderr, "kernel_launch: unexpected shapes: n_in %d out %d ws %zu\n", n_in, out_size, ws_size); grid = -1; return; }
        int dev = 0, cus = 0, per_cu = 0;
        if (hipGetDevice(&dev) != hipSuccess || hipDeviceGetAttribute(&cus, hipDeviceAttributeMultiprocessorCount, dev) != hipSuccess) { grid = -1; return; }
        if (hipFuncSetAttribute((const void*)fwd_kernel, hipFuncAttributeMaxDynamicSharedMemorySize, LDS_BYTES) != hipSuccess) { fprintf(stderr, "kernel_launch: hipFuncSetAttribute failed\n"); grid = -1; return; }
        if (hipOccupancyMaxActiveBlocksPerMultiprocessor(&per_cu, (const void*)fwd_kernel, NWAVES * 64, LDS_BYTES) != hipSuccess || per_cu < 1)
            fprintf(stderr, "kernel_launch: note: occupancy query reports %d workgroups per CU\n", per_cu);
        (void)hipGetLastError();
        grid = cus;
    }
    if (grid < 0) return;
    (void)hipMemsetAsync((char*)d_ws + WS_CTL, 0, CTL_ZERO_BYTES, stream);
    Args a{};
    for (int i = 0; i < 19; ++i) a.in[i] = (const float*)d_in[i];
    a.out = (float*)d_out; a.ws = (unsigned char*)d_ws;
#ifndef PROBE_PROG
    a.ph_lo = 0; a.ph_hi = 5; a.li = 0;
    hipLaunchKernelGGL(fwd_kernel, dim3(grid), dim3(NWAVES * 64), LDS_BYTES, stream, a);
#else
    { static const int prog[] = {PROBE_PROG};
      for (int li = 0; li < (int)(sizeof(prog) / sizeof(prog[0])); ++li) { a.ph_lo = prog[li]; a.ph_hi = prog[li] + 1; a.li = li; hipLaunchKernelGGL(fwd_kernel, dim3(grid), dim3(NWAVES * 64), LDS_BYTES, stream, a); } }
#endif
}
```
